# Optimizing an MI355X kernel written in HIP

```python
import jax, jax.numpy as jnp
from jax import lax
import numpy as np

D_MODEL = 2048
BATCH = 8
SEQ = 2048
DEPTH = 2

N_MIXERS = 2
EPS = 1e-6
ML_HEADS = 8
ML_DQK = 128
ML_DV = 256
ML_CHUNK = 64
GATE_CAP = 15.0
SW_HEADS = 32
SW_KV_HEADS = 4
SW_HEAD_DIM = 64
SW_WINDOW = 128
SW_BLOCK = 128
D_FF = 5632
CONV_WIDTH = 3

kernel_name = "hybrid_mlstm_swa_convffn_adaln"


def rms_norm(x, eps=EPS):
    xf = x.astype(jnp.float32)
    return (xf * lax.rsqrt(jnp.mean(xf * xf, axis=-1, keepdims=True) + eps)).astype(x.dtype)


def modulation(c, w_mod, b_mod):
    m = jax.nn.silu(c) @ w_mod + b_mod
    return jnp.split(m[:, None, :], 6, axis=-1)


def mlstm_mixer(h, w_in, gate_bias, h_norm, w_out):
    B, S, _ = h.shape
    H, dk, dv, L = ML_HEADS, ML_DQK, ML_DV, ML_CHUNK
    f32 = jnp.float32
    proj = h @ w_in
    q, k, v, o, g = jnp.split(proj, [H * dk, 2 * H * dk, 2 * H * dk + H * dv, 2 * H * dk + 2 * H * dv], axis=-1)
    g = g.astype(f32) + gate_bias.astype(f32)
    g = GATE_CAP * jnp.tanh(g / GATE_CAP)
    i_pre = g[..., :H]
    log_f = jax.nn.log_sigmoid(g[..., H:])
    q = q.reshape(B, S, H, dk).astype(f32)
    k = k.reshape(B, S, H, dk).astype(f32) * (dk ** -0.5)
    v = v.reshape(B, S, H, dv).astype(f32)
    NC = S // L

    def chunks(t):
        t = t.reshape(B, NC, L, H, *t.shape[3:])
        return jnp.moveaxis(t, (1, 3), (0, 2))

    causal = jnp.tril(jnp.ones((L, L), dtype=bool))

    def step(carry, xs):
        C, n, m = carry
        qc, kc, vc, ic, fc = xs
        b = jnp.cumsum(fc, axis=-1)
        dmat = jnp.where(causal, b[..., :, None] - b[..., None, :] + ic[..., None, :], -jnp.inf)
        m_inter = b + m[..., None]
        m_t = jnp.maximum(m_inter, jnp.max(dmat, axis=-1))
        w_inter = jnp.exp(m_inter - m_t)
        p = jnp.exp(dmat - m_t[..., None]) * jnp.einsum('bhtd,bhsd->bhts', qc, kc)
        num = w_inter[..., None] * jnp.einsum('bhtd,bhdv->bhtv', qc, C) + jnp.einsum('bhts,bhsv->bhtv', p, vc)
        den = w_inter * jnp.einsum('bhtd,bhd->bht', qc, n) + jnp.sum(p, axis=-1)
        h_c = num / jnp.maximum(jnp.abs(den), jnp.exp(-m_t))[..., None]
        total = b[..., -1]
        g_s = total[..., None] - b + ic
        m_new = jnp.maximum(total + m, jnp.max(g_s, axis=-1))
        w_s = jnp.exp(g_s - m_new[..., None])
        decay = jnp.exp(total + m - m_new)
        C_new = decay[..., None, None] * C + jnp.einsum('bhs,bhsd,bhsv->bhdv', w_s, kc, vc)
        n_new = decay[..., None] * n + jnp.einsum('bhs,bhsd->bhd', w_s, kc)
        return (C_new, n_new, m_new), h_c

    init = (jnp.zeros((B, H, dk, dv), f32), jnp.zeros((B, H, dk), f32), jnp.zeros((B, H), f32))
    _, hs = lax.scan(step, init, (chunks(q), chunks(k), chunks(v), chunks(i_pre), chunks(log_f)))
    hs = jnp.moveaxis(hs, (0, 2), (1, 3)).reshape(B, S, H, dv)
    hs = rms_norm(hs) * h_norm.astype(f32).reshape(H, dv)
    out = jax.nn.sigmoid(o.astype(f32)) * hs.reshape(B, S, H * dv)
    return out.astype(h.dtype) @ w_out


def swa_mixer(h, w_qkv, q_norm, k_norm, sinks, w_out):
    B, S, _ = h.shape
    Hq, Hk, hd, BLK = SW_HEADS, SW_KV_HEADS, SW_HEAD_DIM, SW_BLOCK
    G = Hq // Hk
    f32 = jnp.float32
    qkv = h @ w_qkv
    q, k, v = jnp.split(qkv, [Hq * hd, Hq * hd + Hk * hd], axis=-1)
    q = rms_norm(q.reshape(B, S, Hk, G, hd)) * q_norm
    k = rms_norm(k.reshape(B, S, Hk, hd)) * k_norm
    v = v.reshape(B, S, Hk, hd)
    NB = S // BLK
    q_blocks = q.reshape(B, NB, BLK, Hk, G, hd).swapaxes(0, 1)

    def band(t):
        tp = jnp.pad(t, ((0, 0), (BLK, 0), (0, 0), (0, 0)))
        tb = tp.reshape(B, NB + 1, BLK, Hk, hd)
        return jnp.concatenate([tb[:, :-1], tb[:, 1:]], axis=2).swapaxes(0, 1)

    r = jnp.arange(2 * BLK)
    i = jnp.arange(BLK)
    rel = BLK + i[:, None] - r[None, :]
    band_mask = (rel >= 0) & (rel < SW_WINDOW)
    scale = hd ** -0.5
    sink_logits = sinks.astype(f32).reshape(Hk, G)[None, :, :, None, None]

    def block_attn(args):
        j, qb, kb, vb = args
        valid = band_mask & (r[None, :] + j * BLK >= BLK)
        s = jnp.einsum('bikgd,brkd->bkgir', qb.astype(f32), kb.astype(f32)) * scale
        s = jnp.where(valid, s, -jnp.inf)
        sink = jnp.broadcast_to(sink_logits, s.shape[:-1] + (1,))
        p = jax.nn.softmax(jnp.concatenate([s, sink], axis=-1), axis=-1)[..., :-1]
        return jnp.einsum('bkgir,brkd->bikgd', p, vb.astype(f32)).astype(qb.dtype)

    out = lax.map(block_attn, (jnp.arange(NB), q_blocks, band(k), band(v)))
    out = out.swapaxes(0, 1).reshape(B, S, Hq * hd)
    return out @ w_out


def conv_ffn(h, w_up, conv_w, conv_b, w_down):
    S = h.shape[1]
    u = h @ w_up
    up = jnp.pad(u, ((0, 0), (CONV_WIDTH - 1, 0), (0, 0)))
    u = sum(up[:, j:j + S] * conv_w[j] for j in range(CONV_WIDTH)) + conv_b
    gate, val = jnp.split(u, 2, axis=-1)
    return (jax.nn.silu(gate) * val) @ w_down


def setup_inputs(seed: int = 0) -> dict:
    key = jax.random.key(seed)
    ks = jax.random.split(key, 24)
    D, F = D_MODEL, D_FF
    H = ML_HEADS
    ml_in = 2 * H * ML_DQK + 2 * H * ML_DV + 2 * H
    sw_in = (SW_HEADS + 2 * SW_KV_HEADS) * SW_HEAD_DIM

    def nrm(k, shape, scale):
        return jax.random.normal(k, shape, jnp.float32) * scale

    f_bias = jnp.linspace(3.0, 6.0, H, dtype=jnp.float32)
    gate_bias = jnp.concatenate([nrm(ks[4], (H,), 0.1), f_bias + nrm(ks[5], (H,), 0.1)])
    return {
        "x": nrm(ks[0], (BATCH, SEQ, D), 1.0),
        "c": nrm(ks[1], (BATCH, D), 1.0),
        "l0_w_mod": nrm(ks[2], (D, 6 * D), 0.5 * D ** -0.5),
        "l0_b_mod": nrm(ks[3], (6 * D,), 0.01),
        "l0_w_in": nrm(ks[6], (D, ml_in), D ** -0.5),
        "l0_gate_bias": gate_bias,
        "l0_h_norm": 1.0 + nrm(ks[7], (H * ML_DV,), 0.02),
        "l0_w_out": nrm(ks[8], (H * ML_DV, D), (H * ML_DV) ** -0.5),
        "l0_w_up": nrm(ks[9], (D, 2 * F), D ** -0.5),
        "l0_conv_w": nrm(ks[10], (CONV_WIDTH, 2 * F), CONV_WIDTH ** -0.5),
        "l0_conv_b": nrm(ks[11], (2 * F,), 0.01),
        "l0_w_down": nrm(ks[12], (F, D), F ** -0.5),
        "l1_w_mod": nrm(ks[13], (D, 6 * D), 0.5 * D ** -0.5),
        "l1_b_mod": nrm(ks[14], (6 * D,), 0.01),
        "l1_w_qkv": nrm(ks[15], (D, sw_in), D ** -0.5),
        "l1_q_norm": 1.0 + nrm(ks[16], (SW_HEAD_DIM,), 0.02),
        "l1_k_norm": 1.0 + nrm(ks[17], (SW_HEAD_DIM,), 0.02),
        "l1_sinks": nrm(ks[18], (SW_HEADS,), 1.0),
        "l1_w_out": nrm(ks[19], (SW_HEADS * SW_HEAD_DIM, D), (SW_HEADS * SW_HEAD_DIM) ** -0.5),
        "l1_w_up": nrm(ks[20], (D, 2 * F), D ** -0.5),
        "l1_conv_w": nrm(ks[21], (CONV_WIDTH, 2 * F), CONV_WIDTH ** -0.5),
        "l1_conv_b": nrm(ks[22], (2 * F,), 0.01),
        "l1_w_down": nrm(ks[23], (F, D), F ** -0.5),
    }


def reference(x, c, l0_w_mod, l0_b_mod, l0_w_in, l0_gate_bias, l0_h_norm, l0_w_out, l0_w_up, l0_conv_w, l0_conv_b, l0_w_down, l1_w_mod, l1_b_mod, l1_w_qkv, l1_q_norm, l1_k_norm, l1_sinks, l1_w_out, l1_w_up, l1_conv_w, l1_conv_b, l1_w_down):
    mod_params = [(l0_w_mod, l0_b_mod), (l1_w_mod, l1_b_mod)]
    ffn_params = [(l0_w_up, l0_conv_w, l0_conv_b, l0_w_down), (l1_w_up, l1_conv_w, l1_conv_b, l1_w_down)]
    for layer in range(DEPTH):
        sh1, sc1, g1, sh2, sc2, g2 = modulation(c, *mod_params[layer])
        hm = rms_norm(x) * (1.0 + sc1) + sh1
        if layer % N_MIXERS == 0:
            y = mlstm_mixer(hm, l0_w_in, l0_gate_bias, l0_h_norm, l0_w_out)
        else:
            y = swa_mixer(hm, l1_w_qkv, l1_q_norm, l1_k_norm, l1_sinks, l1_w_out)
        x = x + g1 * y
        hf = rms_norm(x) * (1.0 + sc2) + sh2
        x = x + g2 * conv_ffn(hf, *ffn_params[layer])
    return x
```

```cpp
#include <hip/hip_runtime.h>
#include <hip/hip_cooperative_groups.h>
#include <cstdio>
#include <cstdint>
#include <cmath>
namespace cg = cooperative_groups;
namespace pg8 {
#define PG8_LAS __attribute__((address_space(3)))
typedef unsigned short bf16_t;
typedef short bf16x8 __attribute__((ext_vector_type(8)));
typedef float f32x4 __attribute__((ext_vector_type(4)));
typedef unsigned u32x4 __attribute__((ext_vector_type(4)));
constexpr int BM = 256, BK = 64, HALF = 128, HTB = HALF * BK * 2  , STAGE_BYTES = 8 * HTB, NXCD = 8, WGM = 8;

__host__ __device__ __forceinline__ int lds_byte(int r, int c) { const int st = (r >> 4) * 2 + (c >> 5), rr = r & 15, cc = c & 31, ob = rr * 64 + cc * 2; return st * 1024 + (ob ^ (((ob >> 9) & 1) << 5)); }
__host__ __device__ __forceinline__ void stage_rc(int b, int& R, int& C) { const int st = b / 1024, sb = b % 1024, swz = sb ^ (((sb >> 9) & 1) << 5); R = (st >> 1) * 16 + swz / 64; C = (st & 1) * 32 + (swz % 64) / 2; }
__host__ __device__ __forceinline__ int perm32(int rho) { const int n = rho >> 4, i = rho & 15; return 8 * (i >> 2) + 4 * n + (i & 3); }

struct Unit { int pm, pn; };
struct Gemm { const bf16_t* A; const bf16_t* Bt; int M, N, K; };

struct StaticOrder {
    int nM, nN, nwg, G, c;
    __host__ __device__ void init(int M, int N, int G_, int c_) { nM = M / BM; nN = N / BM; nwg = nM * nN; G = G_; c = c_; }
    __host__ __device__ bool next(int i, Unit& u) const {
        const long L = (long)i * G + c; if (L >= nwg) return false;
        int wgid = (int)L; { const int q = nwg / NXCD, r = nwg % NXCD, xcd = wgid % NXCD, off = wgid / NXCD; wgid = (xcd < r ? xcd * (q + 1) : r * (q + 1) + (xcd - r) * q) + off; }
        const int nig = WGM * nN, gid = wgid / nig, fm = gid * WGM, gsz = (nM - fm) < WGM ? (nM - fm) : WGM;
        u.pm = fm + ((wgid % nig) % gsz); u.pn = (wgid % nig) / gsz; return true;
    }
    __device__ __forceinline__ void a_ready(const Unit&) const {}
    __device__ __forceinline__ void done(const Unit&) const {}
};

__device__ __forceinline__ unsigned cvt_pk_bf16(float lo, float hi) { unsigned r; asm volatile("v_cvt_pk_bf16_f32 %0, %1, %2" : "=v"(r) : "v"(lo), "v"(hi)); return r; }
typedef float f32x2 __attribute__((ext_vector_type(2)));
__device__ __forceinline__ f32x2 gelu_pk(f32x2 v) {
    const f32x2 av = __builtin_elementwise_abs(v), d = av * 0.2316418882f + 1.0f;
    f32x2 t; t.x = __builtin_amdgcn_rcpf(d.x); t.y = __builtin_amdgcn_rcpf(d.y);
    f32x2 q = t * 0.5307027145f + (-0.7265760135f); q = q * t + 0.7107068705f; q = q * t + (-0.142248368f); q = q * t + 0.127414796f; q = q * t;
    const f32x2 s = (v * v) * (-0.72134752044f);
    f32x2 e; e.x = __builtin_amdgcn_exp2f(s.x); e.y = __builtin_amdgcn_exp2f(s.y);
    const f32x2 m = v * (q * e), r = v - m;
    f32x2 o; o.x = v.x < 0.f ? m.x : r.x; o.y = v.y < 0.f ? m.y : r.y; return o;
}

template <int ACT  > struct EpiBf16 {
    static constexpr bool PERM = true, AFTER_DRAIN = false; static_assert(ACT == 0 || ACT == 1, "EpiBf16: ACT is 0 (none) or 1 (gelu_pk)");
    bf16_t* O; int ldc; const float* bias; int split_cols; size_t split_stride; float scale0;
    __device__ __forceinline__ void operator()(const f32x4 (&acc)[2][2][4][2], const Unit& u, int wr, int wc, int fr, int fq) const {
        const int row0 = u.pm * BM + wr * 64 + fr; int colt = u.pn * BM; bf16_t* base = O;
        float sc = 1.f; if (split_cols) { const int t = colt / split_cols; base += (size_t)t * split_stride; colt -= t * split_cols; if (t == 0) sc = scale0; }
        const int col0 = colt + wc * 32 + 8 * fq, bcol0 = u.pn * BM + wc * 32 + 8 * fq;
        f32x4 bv[2][2];
#pragma unroll
        for (int bj = 0; bj < 2; ++bj)
#pragma unroll
            for (int n = 0; n < 2; ++n) bv[bj][n] = bias ? *(const f32x4*)(bias + bcol0 + bj * HALF + 4 * n) : (f32x4){0.f, 0.f, 0.f, 0.f};
#pragma unroll
        for (int ai = 0; ai < 2; ++ai)
#pragma unroll
            for (int m = 0; m < 4; ++m) { bf16_t* rowp = base + (size_t)(row0 + ai * HALF + m * 16) * ldc + col0;
#pragma unroll
                for (int bj = 0; bj < 2; ++bj) { f32x4 v0 = acc[ai][bj][m][0] + bv[bj][0], v1 = acc[ai][bj][m][1] + bv[bj][1];
                    if (ACT == 1) { f32x2 a = gelu_pk((f32x2){v0[0], v0[1]}), b = gelu_pk((f32x2){v0[2], v0[3]}), c = gelu_pk((f32x2){v1[0], v1[1]}), d = gelu_pk((f32x2){v1[2], v1[3]});
                        v0 = (f32x4){a.x, a.y, b.x, b.y}; v1 = (f32x4){c.x, c.y, d.x, d.y}; }
                    v0 = v0 * sc; v1 = v1 * sc; u32x4 w; w.x = cvt_pk_bf16(v0[0], v0[1]); w.y = cvt_pk_bf16(v0[2], v0[3]); w.z = cvt_pk_bf16(v1[0], v1[1]); w.w = cvt_pk_bf16(v1[2], v1[3]);
                    *(u32x4*)(rowp + bj * HALF) = w; } }
    }
};
struct EpiResGate {
    static constexpr bool PERM = false, AFTER_DRAIN = false;
    const float* res; float* out; const float* gate; int gstride;
    __device__ __forceinline__ void operator()(const f32x4 (&acc)[2][2][4][2], const Unit& u, int wr, int wc, int fr, int fq) const {
        const int b = (u.pm * BM) >> 11;
        const int col0 = u.pn * BM + wc * 32 + 4 * fq;
        f32x4 gv[2][2];
#pragma unroll
        for (int bj = 0; bj < 2; ++bj)
#pragma unroll
            for (int n = 0; n < 2; ++n) gv[bj][n] = *(const f32x4*)(gate + (size_t)b * gstride + col0 + bj * HALF + n * 16);
#pragma unroll
        for (int ai = 0; ai < 2; ++ai)
#pragma unroll
            for (int m = 0; m < 4; ++m) { const size_t off = (size_t)(u.pm * BM + ai * HALF + wr * 64 + m * 16 + fr) * 2048 + col0;
#pragma unroll
                for (int bj = 0; bj < 2; ++bj)
#pragma unroll
                    for (int n = 0; n < 2; ++n) { const f32x4 r = *(const f32x4*)(res + off + bj * HALF + n * 16);
                        *(f32x4*)(out + off + bj * HALF + n * 16) = r + gv[bj][n] * acc[ai][bj][m][n]; }
                if (m & 1) asm volatile("" ::: "memory"); }
    }
};
template <class Epi, class Sched, bool ALIGN_EPI = false, bool SP2 = false>
__device__ __forceinline__ void gemm_phase(PG8_LAS unsigned char* lds, const Gemm g, const Sched& S, const Epi& E) {
    const int tid = threadIdx.x, wid = __builtin_amdgcn_readfirstlane(tid >> 6), lane = tid & 63, wr = wid >> 2, wc = wid & 3, fr = lane & 15, fq = lane >> 4;
    const int K = g.K, nt = K / BK;
    unsigned voffA[2], voffB[2];
#pragma unroll
    for (int i = 0; i < 2; ++i) { int R, C; stage_rc(tid * 16 + i * 8192, R, C); const int Rb = Epi::PERM ? ((R & ~31) + perm32(R & 31)) : R;
        voffA[i] = (unsigned)(R * K + C) * 2u; voffB[i] = (unsigned)(Rb * K + C) * 2u; }
    const size_t kstep = (size_t)(BK * 2);
    const size_t hstep = (size_t)HALF * K * 2;
    const size_t tstep = 2 * hstep;
    const unsigned ldsw = (unsigned)wid * 1024u;
    const int aoff = lds_byte(wr * 64 + fr, fq * 8), boff = lds_byte(wc * 32 + fr, fq * 8);
#define PG8_SA(b, h) (((b) * 2 + (h)) * HTB)
#define PG8_SB(b, h) ((4 + (b) * 2 + (h)) * HTB)
#define PG8_STAGE(bufoff, gbase, voff) do { _Pragma("unroll") for (int _i = 0; _i < 2; ++_i) \
        __builtin_amdgcn_global_load_lds((const unsigned*)((const char*)(gbase) + (voff)[_i]), (PG8_LAS unsigned*)(lds + (bufoff) + ldsw + _i * 8192), 16, 0, 0); } while (0)
#define PG8_LDA(dst, b, h) do { _Pragma("unroll") for (int m = 0; m < 4; ++m) _Pragma("unroll") for (int k = 0; k < 2; ++k) dst[m][k] = *(const PG8_LAS bf16x8*)(lds + PG8_SA(b, h) + aoff + m * 2048 + k * 1024); } while (0)
#define PG8_LDB(dst, b, h) do { _Pragma("unroll") for (int n = 0; n < 2; ++n) _Pragma("unroll") for (int k = 0; k < 2; ++k) dst[n][k] = *(const PG8_LAS bf16x8*)(lds + PG8_SB(b, h) + boff + n * 2048 + k * 1024); } while (0)
#define PG8_MMA(ai, bj, At, Bt) do { __builtin_amdgcn_s_setprio(1); _Pragma("unroll") for (int m = 0; m < 4; ++m) _Pragma("unroll") for (int n = 0; n < 2; ++n) _Pragma("unroll") for (int k = 0; k < 2; ++k) \
        acc[ai][bj][m][n] = __builtin_amdgcn_mfma_f32_16x16x32_bf16(Bt[n][k], At[m][k], acc[ai][bj][m][n], 0, 0, 0); __builtin_amdgcn_s_setprio(0); } while (0)
#define PG8_WAIT_V(n) asm volatile("s_waitcnt vmcnt(" #n ")" ::: "memory")
#define PG8_WAIT_L(n) asm volatile("s_waitcnt lgkmcnt(" #n ")" ::: "memory")
#define PG8_BAR __builtin_amdgcn_s_barrier()
#define PG8_SCHED __builtin_amdgcn_sched_barrier(0)
    Unit cur, nxt; int ui = 0;
    if (!S.next(0, cur)) return;
    f32x4 acc[2][2][4][2];
#pragma unroll
    for (int a = 0; a < 2; ++a)
#pragma unroll
        for (int b = 0; b < 2; ++b)
#pragma unroll
            for (int m = 0; m < 4; ++m)
#pragma unroll
                for (int n = 0; n < 2; ++n) acc[a][b][m][n] = (f32x4){0.f, 0.f, 0.f, 0.f};
    bf16x8 At[4][2], B0[2][2], B1[2][2];
    const char* cA = (const char*)g.A + (size_t)cur.pm * tstep; const char* cB = (const char*)g.Bt + (size_t)cur.pn * tstep;
    S.a_ready(cur);
    if constexpr (SP2) {
        PG8_STAGE(PG8_SB(0, 0), cB, voffB); PG8_STAGE(PG8_SB(0, 1), cB + hstep, voffB); PG8_STAGE(PG8_SA(0, 0), cA, voffA); PG8_STAGE(PG8_SA(0, 1), cA + hstep, voffA);
        if (wr == 1) PG8_BAR;
        PG8_WAIT_V(2); PG8_BAR;
        PG8_STAGE(PG8_SB(1, 0), cB + kstep, voffB); PG8_STAGE(PG8_SA(1, 0), cA + kstep, voffA); PG8_STAGE(PG8_SB(1, 1), cB + hstep + kstep, voffB);
        PG8_WAIT_V(6); PG8_BAR;
    } else {
        PG8_STAGE(PG8_SB(0, 0), cB, voffB); PG8_STAGE(PG8_SA(0, 0), cA, voffA); PG8_STAGE(PG8_SB(0, 1), cB + hstep, voffB); PG8_STAGE(PG8_SA(0, 1), cA + hstep, voffA);
        if (wr == 1) PG8_BAR;
        PG8_WAIT_V(4); PG8_BAR;
        PG8_STAGE(PG8_SB(1, 0), cB + kstep, voffB); PG8_STAGE(PG8_SA(1, 0), cA + kstep, voffA); PG8_STAGE(PG8_SB(1, 1), cB + hstep + kstep, voffB);
        PG8_WAIT_V(6); PG8_BAR;
    }
    for (;;) {
        const bool has_next = S.next(ui + 1, nxt);
        const char* nA = has_next ? (const char*)g.A + (size_t)nxt.pm * tstep : cA; const char* nB = has_next ? (const char*)g.Bt + (size_t)nxt.pn * tstep : cB;
        for (int t = 0; t < nt; t += 2) {
            const bool last = (t == nt - 2);
            const char* a1 = cA + (size_t)(t + 1) * kstep;
            const char* a2 = last ? nA : cA + (size_t)(t + 2) * kstep; const char* b2 = last ? nB : cB + (size_t)(t + 2) * kstep;
            const char* a3 = a2 + kstep; const char* b3 = b2 + kstep;
            if (last && has_next) S.a_ready(nxt);
            if constexpr (SP2) {
            PG8_LDB(B0, 0, 0); PG8_LDB(B1, 0, 1); PG8_SCHED; PG8_LDA(At, 0, 0); PG8_STAGE(PG8_SA(1, 1), a1 + hstep, voffA);
            PG8_WAIT_V(8); PG8_WAIT_L(0); PG8_BAR; PG8_MMA(0, 0, At, B0); PG8_MMA(0, 1, At, B1); PG8_BAR; PG8_SCHED;
            PG8_LDA(At, 0, 1); PG8_STAGE(PG8_SB(0, 0), b2, voffB); PG8_STAGE(PG8_SB(0, 1), b2 + hstep, voffB); PG8_STAGE(PG8_SA(0, 0), a2, voffA);
            PG8_WAIT_V(8); PG8_WAIT_L(0); PG8_BAR; PG8_MMA(1, 0, At, B0); PG8_MMA(1, 1, At, B1); PG8_BAR; PG8_SCHED;
            PG8_LDB(B0, 1, 0); PG8_LDB(B1, 1, 1); PG8_SCHED; PG8_LDA(At, 1, 0); PG8_STAGE(PG8_SA(0, 1), a2 + hstep, voffA);
            PG8_WAIT_V(8); PG8_WAIT_L(0); PG8_BAR; PG8_MMA(0, 0, At, B0); PG8_MMA(0, 1, At, B1); PG8_BAR; PG8_SCHED;
            PG8_LDA(At, 1, 1); PG8_STAGE(PG8_SB(1, 0), b3, voffB); PG8_STAGE(PG8_SB(1, 1), b3 + hstep, voffB); PG8_STAGE(PG8_SA(1, 0), a3, voffA);
            PG8_WAIT_V(8); PG8_WAIT_L(0); PG8_BAR; PG8_MMA(1, 0, At, B0); PG8_MMA(1, 1, At, B1); PG8_BAR; PG8_SCHED;
            } else {
            PG8_LDB(B0, 0, 0); PG8_SCHED; PG8_LDA(At, 0, 0); PG8_STAGE(PG8_SA(1, 1), a1 + hstep, voffA);
            PG8_WAIT_L(8); PG8_BAR; PG8_WAIT_L(0); PG8_MMA(0, 0, At, B0); PG8_BAR; PG8_SCHED;
            PG8_LDB(B1, 0, 1); PG8_STAGE(PG8_SB(0, 0), b2, voffB);
            PG8_BAR; PG8_WAIT_L(0); PG8_MMA(0, 1, At, B1); PG8_BAR;
            PG8_LDA(At, 0, 1); PG8_STAGE(PG8_SA(0, 0), a2, voffA);
            PG8_BAR; PG8_WAIT_L(0); PG8_MMA(1, 0, At, B0); PG8_BAR; PG8_SCHED;
            PG8_STAGE(PG8_SB(0, 1), b2 + hstep, voffB);
            PG8_WAIT_V(6); PG8_BAR; PG8_MMA(1, 1, At, B1); PG8_BAR;
            PG8_LDB(B0, 1, 0); PG8_SCHED; PG8_LDA(At, 1, 0); PG8_STAGE(PG8_SA(0, 1), a2 + hstep, voffA);
            PG8_WAIT_L(8); PG8_BAR; PG8_WAIT_L(0); PG8_MMA(0, 0, At, B0); PG8_BAR; PG8_SCHED;
            PG8_LDB(B1, 1, 1); PG8_STAGE(PG8_SB(1, 0), b3, voffB);
            PG8_BAR; PG8_WAIT_L(0); PG8_MMA(0, 1, At, B1); PG8_BAR;
            PG8_LDA(At, 1, 1); PG8_STAGE(PG8_SA(1, 0), a3, voffA);
            PG8_BAR; PG8_WAIT_L(0); PG8_MMA(1, 0, At, B0); PG8_BAR; PG8_SCHED;
            PG8_STAGE(PG8_SB(1, 1), b3 + hstep, voffB);
            PG8_WAIT_V(6); PG8_BAR; PG8_MMA(1, 1, At, B1); PG8_BAR;
            }
        }
        if constexpr (ALIGN_EPI) { if (wr == 0) PG8_BAR; }
        if constexpr (!Epi::AFTER_DRAIN) { E(acc, cur, wr, wc, fr, fq); S.done(cur); }
        if (!has_next) break;
#pragma unroll
        for (int a = 0; a < 2; ++a)
#pragma unroll
            for (int b = 0; b < 2; ++b)
#pragma unroll
                for (int m = 0; m < 4; ++m)
#pragma unroll
                    for (int n = 0; n < 2; ++n) acc[a][b][m][n] = (f32x4){0.f, 0.f, 0.f, 0.f};
        cur = nxt; cA = nA; cB = nB; ++ui;
        if constexpr (ALIGN_EPI) { if (wr == 1) PG8_BAR; }
    }
    PG8_WAIT_V(0);
    if constexpr (!ALIGN_EPI) { if (wr == 0) PG8_BAR; }
    PG8_BAR;
    if constexpr (Epi::AFTER_DRAIN) { E.fused(acc, cur, wr, wc, fr, fq, lds, wid, lane); S.done(cur); }
#undef PG8_SA
#undef PG8_SB
#undef PG8_STAGE
#undef PG8_LDA
#undef PG8_LDB
#undef PG8_MMA
#undef PG8_WAIT_V
#undef PG8_WAIT_L
#undef PG8_BAR
#undef PG8_SCHED
}
}

#define LAS __attribute__((address_space(3)))
typedef unsigned short bf16;
typedef float f32x4 __attribute__((ext_vector_type(4)));
typedef short bf16x8 __attribute__((ext_vector_type(8)));
typedef short s16x4 __attribute__((ext_vector_type(4)));
typedef unsigned u32x4 __attribute__((ext_vector_type(4)));
typedef unsigned u32x2 __attribute__((ext_vector_type(2)));

constexpr int NWAVES = 8, NTHR = 512;
constexpr int M = 16384, D = 2048, SEQ = 2048;
constexpr int N_IN = 6144, LD_WIN = 6160, FF = 5632, FF2 = 11264, N_QKV = 2560, MODW = 12288;
constexpr float EPS = 1e-6f;
constexpr int LDS_BYTES = 147456;

constexpr size_t MiB = 1u << 20;
constexpr size_t WS_MOD = 0;
constexpr size_t MOD_BYTES = 2 * 8 * 12288 * 4;
constexpr size_t WS_G = 1 * MiB;
constexpr size_t WS_SS = 2 * MiB;
constexpr size_t WS_WG = 6 * MiB;
constexpr size_t WS_W_A = 8 * MiB;
constexpr size_t WS_W_B = 32 * MiB;
constexpr size_t WS_W_C = 40 * MiB;
constexpr size_t WS_W_D = 84 * MiB;
constexpr size_t WS_A2 = 112 * MiB;
constexpr size_t WS_XN = 112 * MiB;
constexpr size_t WS_U = 288 * MiB;
constexpr size_t WS_QKVO = 288 * MiB;
constexpr size_t WS_H = 480 * MiB;
constexpr size_t WS_HS = 544 * MiB;
constexpr size_t WS_END = 640 * MiB;

#define LDS_WAIT() asm volatile("s_waitcnt lgkmcnt(0)" ::: "memory")
__device__ __forceinline__ unsigned f2bf(float f) { unsigned u = __builtin_bit_cast(unsigned, f); return (u + 0x7fffu + ((u >> 16) & 1u)) >> 16; }
__device__ __forceinline__ unsigned pk2(float lo, float hi) { return pg8::cvt_pk_bf16(lo, hi); }
__device__ __forceinline__ float bflo(unsigned w) { return __builtin_bit_cast(float, w << 16); }
__device__ __forceinline__ float bfhi(unsigned w) { return __builtin_bit_cast(float, w & 0xffff0000u); }
__device__ __forceinline__ float wave_sum(float v) {
#pragma unroll
    for (int o = 1; o < 64; o <<= 1) v += __shfl_xor(v, o);
    return v;
}
__device__ __forceinline__ f32x4 mfma16(bf16x8 a, bf16x8 b, f32x4 c) { return __builtin_amdgcn_mfma_f32_16x16x32_bf16(a, b, c, 0, 0, 0); }

__device__ __forceinline__ void transpose_item(const float* W, int K, int ldw, int ncols, bf16* WT, LAS float* scr, int item, int lane) {
    const int nblk = ncols / 32, kb = item / nblk, nb = item % nblk, k0 = 64 * kb, n0 = 32 * nb;
#pragma unroll 8
    for (int i = 0; i < 32; ++i) { const int kk = 2 * i + (lane >> 5); scr[kk * 33 + (lane & 31)] = W[(size_t)(k0 + kk) * ldw + n0 + (lane & 31)]; }
    LDS_WAIT(); asm volatile("" ::: "memory");
    const int c = lane & 7;
#pragma unroll
    for (int j = 0; j < 4; ++j) { const int n = (lane >> 3) + 8 * j; const LAS float* s = scr + (8 * c) * 33 + n;
        u32x4 o; o.x = pk2(s[0 * 33], s[1 * 33]); o.y = pk2(s[2 * 33], s[3 * 33]); o.z = pk2(s[4 * 33], s[5 * 33]); o.w = pk2(s[6 * 33], s[7 * 33]);
        *(u32x4*)(WT + (size_t)(n0 + n) * K + k0 + 8 * c) = o; }
    LDS_WAIT(); asm volatile("" ::: "memory");
}
struct ConvJob { const float* W; bf16* WT; int K, ldw, ncols, items; };
__device__ __forceinline__ void convert_weights(const ConvJob& j0, const ConvJob& j1, const ConvJob& j2, const ConvJob& j3, LAS unsigned char* lds, int gw, int NGW, int wave, int lane) {
    LAS float* scr = (LAS float*)(lds + wave * 16384);
    const int total = j0.items + j1.items + j2.items + j3.items;
    for (int it = gw; it < total; it += NGW) {
        int r = it;
        if (r < j0.items) { transpose_item(j0.W, j0.K, j0.ldw, j0.ncols, j0.WT, scr, r, lane); continue; } r -= j0.items;
        if (r < j1.items) { transpose_item(j1.W, j1.K, j1.ldw, j1.ncols, j1.WT, scr, r, lane); continue; } r -= j1.items;
        if (r < j2.items) { transpose_item(j2.W, j2.K, j2.ldw, j2.ncols, j2.WT, scr, r, lane); continue; } r -= j2.items;
        transpose_item(j3.W, j3.K, j3.ldw, j3.ncols, j3.WT, scr, r, lane);
    }
}
__device__ __forceinline__ void mod_task(const float* c, const float* wmod, const float* bmod, float* modl, int cg, int kh, LAS unsigned char* lds, int tid, int wave, int lane) {
    LAS float* sl = (LAS float*)lds;
    LAS float* red = (LAS float*)(lds + 32768);
    for (int e = tid; e < 8192; e += NTHR) { const int kk = e >> 3, b = e & 7; const float cv = c[b * 2048 + kh * 1024 + kk]; sl[e] = cv / (1.f + __expf(-cv)); }
    __syncthreads();
    const float* wp = wmod + (size_t)(kh * 1024 + wave * 128) * MODW + cg * 256 + lane * 4;
    f32x4 acc[8];
#pragma unroll
    for (int b = 0; b < 8; ++b) acc[b] = (f32x4){0.f, 0.f, 0.f, 0.f};
#pragma unroll 4
    for (int k = 0; k < 128; ++k) {
        const f32x4 wv = *(const f32x4*)(wp + (size_t)k * MODW);
        const LAS f32x4* sp = (const LAS f32x4*)(sl + (wave * 128 + k) * 8);
        const f32x4 s0 = sp[0], s1 = sp[1];
        acc[0] += s0.x * wv; acc[1] += s0.y * wv; acc[2] += s0.z * wv; acc[3] += s0.w * wv;
        acc[4] += s1.x * wv; acc[5] += s1.y * wv; acc[6] += s1.z * wv; acc[7] += s1.w * wv;
    }
#pragma unroll
    for (int b = 0; b < 8; ++b) *(LAS f32x4*)(red + (wave * 8 + b) * 256 + lane * 4) = acc[b];
    __syncthreads();
    for (int o = tid; o < 2048; o += NTHR) { const int b = o >> 8, col = o & 255; float s = 0.f;
#pragma unroll
        for (int w = 0; w < 8; ++w) s += red[(w * 8 + b) * 256 + col];
        if (kh == 0) s += bmod[cg * 256 + col];
        atomicAdd(modl + (size_t)b * MODW + cg * 256 + col, s); }
    __syncthreads();
}

__device__ __forceinline__ void norm_mod_rows(const float* X, bf16* XN, const float* shift, const float* scale, int gw, int NGW, int lane) {
    for (int r = gw; r < M; r += NGW) {
        const int b = r >> 11; const float* xr = X + (size_t)r * D;
        f32x4 v[4][2]; float s = 0.f;
#pragma unroll
        for (int j = 0; j < 4; ++j) { const f32x4* p = (const f32x4*)(xr + 8 * lane + 512 * j); v[j][0] = p[0]; v[j][1] = p[1];
            s += (v[j][0].x * v[j][0].x + v[j][0].y * v[j][0].y) + (v[j][0].z * v[j][0].z + v[j][0].w * v[j][0].w);
            s += (v[j][1].x * v[j][1].x + v[j][1].y * v[j][1].y) + (v[j][1].z * v[j][1].z + v[j][1].w * v[j][1].w); }
        s = wave_sum(s); const float rstd = 1.f / sqrtf(s * (1.f / 2048.f) + EPS);
        const float* sh = shift + (size_t)b * MODW; const float* sc = scale + (size_t)b * MODW;
#pragma unroll
        for (int j = 0; j < 4; ++j) { const int col = 8 * lane + 512 * j;
            const f32x4 a0 = *(const f32x4*)(sc + col), a1 = *(const f32x4*)(sc + col + 4), h0 = *(const f32x4*)(sh + col), h1 = *(const f32x4*)(sh + col + 4);
            const f32x4 o0 = v[j][0] * rstd * (a0 + 1.f) + h0, o1 = v[j][1] * rstd * (a1 + 1.f) + h1;
            u32x4 w; w.x = pk2(o0.x, o0.y); w.y = pk2(o0.z, o0.w); w.z = pk2(o1.x, o1.y); w.w = pk2(o1.z, o1.w);
            *(u32x4*)(XN + (size_t)r * D + col) = w; }
    }
}
__device__ __forceinline__ void headnorm_rows(const bf16* H, const bf16* QKVO, const float* SS, const float* hnorm, bf16* HS, int gw, int NGW, int lane) {
    for (int r = gw; r < M; r += NGW) {
#pragma unroll
        for (int j = 0; j < 4; ++j) { const int col = 8 * lane + 512 * j, head = col >> 8;
            const f32x4 s0 = *(const f32x4*)(SS + (size_t)r * 64 + head * 8), s1 = *(const f32x4*)(SS + (size_t)r * 64 + head * 8 + 4);
            const float ssum = ((s0.x + s0.y) + (s0.z + s0.w)) + ((s1.x + s1.y) + (s1.z + s1.w));
            const float rstd = 1.f / sqrtf(ssum * (1.f / 256.f) + EPS);
            const u32x4 hv = *(const u32x4*)(H + (size_t)r * D + col), ov = *(const u32x4*)(QKVO + (size_t)r * N_IN + 4096 + col);
            const f32x4 n0 = *(const f32x4*)(hnorm + col), n1 = *(const f32x4*)(hnorm + col + 4);
            float hh[8] = {bflo(hv.x), bfhi(hv.x), bflo(hv.y), bfhi(hv.y), bflo(hv.z), bfhi(hv.z), bflo(hv.w), bfhi(hv.w)};
            float oo[8] = {bflo(ov.x), bfhi(ov.x), bflo(ov.y), bfhi(ov.y), bflo(ov.z), bfhi(ov.z), bflo(ov.w), bfhi(ov.w)};
            float nn[8] = {n0.x, n0.y, n0.z, n0.w, n1.x, n1.y, n1.z, n1.w};
            float rr[8];
#pragma unroll
            for (int e = 0; e < 8; ++e) rr[e] = hh[e] * rstd * nn[e] / (1.f + __expf(-oo[e]));
            u32x4 w; w.x = pk2(rr[0], rr[1]); w.y = pk2(rr[2], rr[3]); w.z = pk2(rr[4], rr[5]); w.w = pk2(rr[6], rr[7]);
            *(u32x4*)(HS + (size_t)r * D + col) = w; }
    }
}
__device__ __forceinline__ void conv_pass(const bf16* U, bf16* A2, const float* cw, const float* cb, int gtid, int gthreads) {
    for (int task = gtid; task < 704 * 512; task += gthreads) {
        const int cgp = task % 704, rr = task / 704, c0 = cgp * 8, r0 = rr * 32;
        float wg[3][8], wv[3][8], bg[8], bv[8];
#pragma unroll
        for (int j = 0; j < 3; ++j)
#pragma unroll
            for (int e = 0; e < 8; ++e) { wg[j][e] = cw[j * FF2 + c0 + e]; wv[j][e] = cw[j * FF2 + FF + c0 + e]; }
#pragma unroll
        for (int e = 0; e < 8; ++e) { bg[e] = cb[c0 + e]; bv[e] = cb[FF + c0 + e]; }
        float g2[8], g1[8], v2[8], v1[8];
        if ((r0 & 2047) == 0) {
#pragma unroll
            for (int e = 0; e < 8; ++e) { g2[e] = 0.f; g1[e] = 0.f; v2[e] = 0.f; v1[e] = 0.f; }
        } else {
            const u32x4 a = *(const u32x4*)(U + (size_t)(r0 - 2) * FF2 + c0), b = *(const u32x4*)(U + (size_t)(r0 - 1) * FF2 + c0);
            const u32x4 c = *(const u32x4*)(U + (size_t)(r0 - 2) * FF2 + FF + c0), d = *(const u32x4*)(U + (size_t)(r0 - 1) * FF2 + FF + c0);
            g2[0] = bflo(a.x); g2[1] = bfhi(a.x); g2[2] = bflo(a.y); g2[3] = bfhi(a.y); g2[4] = bflo(a.z); g2[5] = bfhi(a.z); g2[6] = bflo(a.w); g2[7] = bfhi(a.w);
            g1[0] = bflo(b.x); g1[1] = bfhi(b.x); g1[2] = bflo(b.y); g1[3] = bfhi(b.y); g1[4] = bflo(b.z); g1[5] = bfhi(b.z); g1[6] = bflo(b.w); g1[7] = bfhi(b.w);
            v2[0] = bflo(c.x); v2[1] = bfhi(c.x); v2[2] = bflo(c.y); v2[3] = bfhi(c.y); v2[4] = bflo(c.z); v2[5] = bfhi(c.z); v2[6] = bflo(c.w); v2[7] = bfhi(c.w);
            v1[0] = bflo(d.x); v1[1] = bfhi(d.x); v1[2] = bflo(d.y); v1[3] = bfhi(d.y); v1[4] = bflo(d.z); v1[5] = bfhi(d.z); v1[6] = bflo(d.w); v1[7] = bfhi(d.w);
        }
#pragma unroll 2
        for (int i = 0; i < 32; ++i) {
            const size_t r = (size_t)(r0 + i);
            const u32x4 a = *(const u32x4*)(U + r * FF2 + c0), c = *(const u32x4*)(U + r * FF2 + FF + c0);
            float g0[8] = {bflo(a.x), bfhi(a.x), bflo(a.y), bfhi(a.y), bflo(a.z), bfhi(a.z), bflo(a.w), bfhi(a.w)};
            float v0[8] = {bflo(c.x), bfhi(c.x), bflo(c.y), bfhi(c.y), bflo(c.z), bfhi(c.z), bflo(c.w), bfhi(c.w)};
            float o[8];
#pragma unroll
            for (int e = 0; e < 8; ++e) {
                const float g = wg[0][e] * g2[e] + wg[1][e] * g1[e] + wg[2][e] * g0[e] + bg[e];
                const float v = wv[0][e] * v2[e] + wv[1][e] * v1[e] + wv[2][e] * v0[e] + bv[e];
                o[e] = g / (1.f + __expf(-g)) * v;
                g2[e] = g1[e]; g1[e] = g0[e]; v2[e] = v1[e]; v1[e] = v0[e];
            }
            u32x4 w; w.x = pk2(o[0], o[1]); w.y = pk2(o[2], o[3]); w.z = pk2(o[4], o[5]); w.w = pk2(o[6], o[7]);
            *(u32x4*)(A2 + r * FF + c0) = w;
        }
    }
}

__device__ __forceinline__ void gate_gemm(const bf16* XN, const bf16* WG, const float* gbias, float* G, int wave, int lane) {
    if (wave >= 4) return;
    const int fr = lane & 15, fq = lane >> 4;
    for (int task = (int)blockIdx.x * 4 + wave; task < 1024; task += 4 * (int)gridDim.x) {
        const int r0 = task * 16;
        const bf16* ap = WG + (size_t)fr * D + fq * 8; const bf16* bp = XN + (size_t)(r0 + fr) * D + fq * 8;
        f32x4 acc = (f32x4){0.f, 0.f, 0.f, 0.f};
#pragma unroll 8
        for (int kk = 0; kk < 64; ++kk) { const bf16x8 a = *(const bf16x8*)(ap + kk * 32), b = *(const bf16x8*)(bp + kk * 32); acc = mfma16(a, b, acc); }
        const f32x4 bi = *(const f32x4*)(gbias + 4 * fq);
        f32x4 o;
#pragma unroll
        for (int i = 0; i < 4; ++i) { float g = 15.f * tanhf((acc[i] + bi[i]) * (1.f / 15.f));
            if (fq >= 2) g = fminf(g, 0.f) - log1pf(__expf(-fabsf(g)));
            o[i] = g; }
        *(f32x4*)(G + (size_t)(r0 + fr) * 16 + 4 * fq) = o;
    }
}

__device__ __forceinline__ void mlstm_phase(LAS unsigned char* lds, const bf16* QKVO, const float* G, bf16* H, float* SS, int tid, int wave, int lane) {
    constexpr int QS = 0, KS = 17408, KT = 34816, VT = 53248, CT = 62464, NS = 79872, RS = 272, TS = 144;
    const int fr = lane & 15, fq = lane >> 4, tt = wave >> 1, vh = wave & 1;
    for (int item = blockIdx.x; item < 256; item += gridDim.x) {
        const int b = item >> 5, h = (item >> 2) & 7, vs = item & 3;
        const size_t rowb = (size_t)b * SEQ;
        for (int e = tid; e < 17408 / 4; e += NTHR) ((LAS unsigned*)(lds + CT))[e] = 0u;
        if (tid < 128) ((LAS float*)(lds + NS))[tid] = 0.f;
        f32x4 Cacc[4];
#pragma unroll
        for (int vt = 0; vt < 4; ++vt) Cacc[vt] = (f32x4){0.f, 0.f, 0.f, 0.f};
        float m_run = 0.f;
        u32x4 rq[2], rk[2], rv; float rig, rfg;
        const int vrow = tid >> 3, vc = tid & 7;
#define ML_LOAD(c) do { \
        _Pragma("unroll") for (int i_ = 0; i_ < 2; ++i_) { const int p_ = tid + 512 * i_, prow_ = p_ >> 4, pc_ = p_ & 15; \
            const bf16* src_ = QKVO + (rowb + 64 * (c) + prow_) * N_IN + h * 128 + pc_ * 8; rq[i_] = *(const u32x4*)src_; rk[i_] = *(const u32x4*)(src_ + 1024); } \
        rv = *(const u32x4*)(QKVO + (rowb + 64 * (c) + vrow) * N_IN + 2048 + h * 256 + vs * 64 + vc * 8); \
        rig = G[(rowb + 64 * (c) + lane) * 16 + h]; rfg = G[(rowb + 64 * (c) + lane) * 16 + 8 + h]; } while (0)
        ML_LOAD(0);
        for (int c = 0; c < 32; ++c) {
            float bsum = rfg;
#pragma unroll
            for (int off = 1; off < 64; off <<= 1) { const float t = __shfl_up(bsum, off); if (lane >= off) bsum += t; }
            const float a = rig - bsum;
            float cm = a;
#pragma unroll
            for (int off = 1; off < 64; off <<= 1) { const float t = __shfl_up(cm, off); if (lane >= off) cm = fmaxf(cm, t); }
            const float Mt = fmaxf(m_run, cm);
            const float M63 = __shfl(Mt, 63), total = __shfl(bsum, 63);
            const float wsg = __expf(a - M63), decay = __expf(m_run - M63), winter = __expf(m_run - Mt), emt = __expf(-(bsum + Mt));
#pragma unroll
            for (int i = 0; i < 2; ++i) { const int p = tid + 512 * i, prow = p >> 4, pc = p & 15;
                *(LAS u32x4*)(lds + QS + prow * RS + pc * 16) = rq[i]; *(LAS u32x4*)(lds + KS + prow * RS + pc * 16) = rk[i];
                const float w = __shfl(wsg, prow & 63);
                const unsigned kw[4] = {rk[i].x, rk[i].y, rk[i].z, rk[i].w};
#pragma unroll
                for (int e = 0; e < 4; ++e) {
                    *(LAS unsigned short*)(lds + KT + (pc * 8 + 2 * e) * TS + prow * 2) = (unsigned short)f2bf(bflo(kw[e]) * w);
                    *(LAS unsigned short*)(lds + KT + (pc * 8 + 2 * e + 1) * TS + prow * 2) = (unsigned short)f2bf(bfhi(kw[e]) * w); } }
            { const unsigned vw[4] = {rv.x, rv.y, rv.z, rv.w};
#pragma unroll
                for (int e = 0; e < 4; ++e) {
                    *(LAS unsigned short*)(lds + VT + (vc * 8 + 2 * e) * TS + vrow * 2) = (unsigned short)(vw[e] & 0xffffu);
                    *(LAS unsigned short*)(lds + VT + (vc * 8 + 2 * e + 1) * TS + vrow * 2) = (unsigned short)(vw[e] >> 16); } }
            __syncthreads();
            if (c + 1 < 32) ML_LOAD(c + 1);
            const int trow = 16 * tt + fr;
            const float Mt_r = __shfl(Mt, trow), wi_r = __shfl(winter, trow), emt_r = __shfl(emt, trow);
            bf16x8 qf[4];
#pragma unroll
            for (int kk = 0; kk < 4; ++kk) qf[kk] = *(const LAS bf16x8*)(lds + QS + trow * RS + kk * 64 + fq * 16);
            float rs = 0.f; unsigned pw[4][2];
#pragma unroll
            for (int st = 0; st < 4; ++st) { f32x4 sa = (f32x4){0.f, 0.f, 0.f, 0.f};
#pragma unroll
                for (int kk = 0; kk < 4; ++kk) { const bf16x8 kf = *(const LAS bf16x8*)(lds + KS + (16 * st + fr) * RS + kk * 64 + fq * 16); sa = mfma16(kf, qf[kk], sa); }
                float pv[4];
#pragma unroll
                for (int i = 0; i < 4; ++i) { const int s = 16 * st + 4 * fq + i; const float as = __shfl(a, s);
                    const float dw = (s <= trow) ? __expf(as - Mt_r) : 0.f; pv[i] = sa[i] * dw; rs += pv[i]; }
                pw[st][0] = pk2(pv[0], pv[1]); pw[st][1] = pk2(pv[2], pv[3]); }
            rs += __shfl_xor(rs, 16); rs += __shfl_xor(rs, 32);
            float qn = 0.f;
#pragma unroll
            for (int kk = 0; kk < 4; ++kk) { const LAS f32x4* np = (const LAS f32x4*)(lds + NS + (32 * kk + 8 * fq) * 4); const f32x4 n0 = np[0], n1 = np[1];
                const u32x4 qw = __builtin_bit_cast(u32x4, qf[kk]);
                qn += bflo(qw.x) * n0.x + bfhi(qw.x) * n0.y + bflo(qw.y) * n0.z + bfhi(qw.y) * n0.w + bflo(qw.z) * n1.x + bfhi(qw.z) * n1.y + bflo(qw.w) * n1.z + bfhi(qw.w) * n1.w; }
            qn += __shfl_xor(qn, 16); qn += __shfl_xor(qn, 32);
            const float den = wi_r * qn + rs, inv = 1.f / fmaxf(fabsf(den), emt_r);
            float ssq = 0.f;
#pragma unroll
            for (int j = 0; j < 2; ++j) { const int vt = 2 * vh + j; f32x4 o1 = (f32x4){0.f, 0.f, 0.f, 0.f}, o2 = (f32x4){0.f, 0.f, 0.f, 0.f};
#pragma unroll
                for (int kb = 0; kb < 2; ++kb) { const s16x4 lo = *(const LAS s16x4*)(lds + VT + (16 * vt + fr) * TS + (32 * kb + 4 * fq) * 2), hi = *(const LAS s16x4*)(lds + VT + (16 * vt + fr) * TS + (32 * kb + 16 + 4 * fq) * 2);
                    const bf16x8 vf = (bf16x8){lo[0], lo[1], lo[2], lo[3], hi[0], hi[1], hi[2], hi[3]};
                    const u32x4 pu = (u32x4){pw[2 * kb][0], pw[2 * kb][1], pw[2 * kb + 1][0], pw[2 * kb + 1][1]};
                    o1 = mfma16(vf, __builtin_bit_cast(bf16x8, pu), o1); }
#pragma unroll
                for (int kk = 0; kk < 4; ++kk) { const bf16x8 cf = *(const LAS bf16x8*)(lds + CT + (16 * vt + fr) * RS + kk * 64 + fq * 16); o2 = mfma16(cf, qf[kk], o2); }
                const f32x4 hv = (o2 * wi_r + o1) * inv;
                ssq += (hv.x * hv.x + hv.y * hv.y) + (hv.z * hv.z + hv.w * hv.w);
                u32x2 w; w.x = pk2(hv.x, hv.y); w.y = pk2(hv.z, hv.w);
                *(u32x2*)(H + (rowb + 64 * c + trow) * D + h * 256 + vs * 64 + 16 * vt + 4 * fq) = w; }
            ssq += __shfl_xor(ssq, 16); ssq += __shfl_xor(ssq, 32);
            if (fq == 0) SS[(rowb + 64 * c + trow) * 64 + h * 8 + vs * 2 + vh] = ssq;
#pragma unroll
            for (int vt = 0; vt < 4; ++vt) Cacc[vt] = Cacc[vt] * decay;
#pragma unroll
            for (int kb = 0; kb < 2; ++kb) { const bf16x8 ktf = *(const LAS bf16x8*)(lds + KT + (16 * wave + fr) * TS + kb * 64 + fq * 16);
#pragma unroll
                for (int vt = 0; vt < 4; ++vt) { const bf16x8 vtf = *(const LAS bf16x8*)(lds + VT + (16 * vt + fr) * TS + kb * 64 + fq * 16); Cacc[vt] = mfma16(ktf, vtf, Cacc[vt]); } }
            float ksum = 0.f;
            if (tid < 128) {
#pragma unroll
                for (int e8 = 0; e8 < 8; ++e8) { const u32x4 w = *(const LAS u32x4*)(lds + KT + tid * TS + e8 * 16);
                    ksum += ((bflo(w.x) + bfhi(w.x)) + (bflo(w.y) + bfhi(w.y))) + ((bflo(w.z) + bfhi(w.z)) + (bflo(w.w) + bfhi(w.w))); } }
            __syncthreads();
#pragma unroll
            for (int vt = 0; vt < 4; ++vt) { u32x2 w; w.x = pk2(Cacc[vt].x, Cacc[vt].y); w.y = pk2(Cacc[vt].z, Cacc[vt].w);
                *(LAS u32x2*)(lds + CT + (16 * vt + fr) * RS + (16 * wave + 4 * fq) * 2) = w; }
            if (tid < 128) { LAS float* ns = (LAS float*)(lds + NS); ns[tid] = decay * ns[tid] + ksum; }
            m_run = total + M63;
        }
#undef ML_LOAD
        __syncthreads();
    }
}

__device__ __forceinline__ void swa_phase(LAS unsigned char* lds, const bf16* QKV, const float* qnw, const float* knw, const float* sinks, bf16* O, int tid, int wave, int lane) {
    constexpr int KSB = 0, KSTR = 144, VTB = 36864, VSTR = 528;
    const int fr = lane & 15, fq = lane >> 4;
    for (int u = blockIdx.x; u < 512; u += gridDim.x) {
        const int b = u >> 6, kvh = (u >> 4) & 3, j = u & 15;
        const size_t rowb = (size_t)b * SEQ;
#pragma unroll
        for (int i = 0; i < 4; ++i) { const int idx = tid + 512 * i, r = idx >> 3, ch = idx & 7; const int pos = 128 * (j - 1) + r;
            u32x4 kv = (u32x4){0u, 0u, 0u, 0u}, vv = (u32x4){0u, 0u, 0u, 0u};
            if (pos >= 0) { const bf16* src = QKV + (rowb + pos) * N_QKV + 2048 + kvh * 64 + ch * 8; kv = *(const u32x4*)src; vv = *(const u32x4*)(src + 256); }
            float kf[8] = {bflo(kv.x), bfhi(kv.x), bflo(kv.y), bfhi(kv.y), bflo(kv.z), bfhi(kv.z), bflo(kv.w), bfhi(kv.w)};
            float ss = 0.f;
#pragma unroll
            for (int e = 0; e < 8; ++e) ss += kf[e] * kf[e];
            ss += __shfl_xor(ss, 1); ss += __shfl_xor(ss, 2); ss += __shfl_xor(ss, 4);
            const float rstd = 1.f / sqrtf(ss * (1.f / 64.f) + EPS);
            const f32x4 w0 = *(const f32x4*)(knw + ch * 8), w1 = *(const f32x4*)(knw + ch * 8 + 4);
            u32x4 ko; ko.x = pk2(kf[0] * rstd * w0.x, kf[1] * rstd * w0.y); ko.y = pk2(kf[2] * rstd * w0.z, kf[3] * rstd * w0.w);
            ko.z = pk2(kf[4] * rstd * w1.x, kf[5] * rstd * w1.y); ko.w = pk2(kf[6] * rstd * w1.z, kf[7] * rstd * w1.w);
            *(LAS u32x4*)(lds + KSB + r * KSTR + ch * 16) = ko;
            const unsigned vw[4] = {vv.x, vv.y, vv.z, vv.w};
#pragma unroll
            for (int e = 0; e < 4; ++e) {
                *(LAS unsigned short*)(lds + VTB + (ch * 8 + 2 * e) * VSTR + r * 2) = (unsigned short)(vw[e] & 0xffffu);
                *(LAS unsigned short*)(lds + VTB + (ch * 8 + 2 * e + 1) * VSTR + r * 2) = (unsigned short)(vw[e] >> 16); } }
        __syncthreads();
        const int head = kvh * 8 + wave; const float sink = sinks[head];
        for (int qt = 0; qt < 8; ++qt) {
            const int qi = 16 * qt + fr; const size_t tok = rowb + 128 * j + qi;
            bf16x8 qf[2];
            { const u32x4 q0 = *(const u32x4*)(QKV + tok * N_QKV + head * 64 + fq * 8), q1 = *(const u32x4*)(QKV + tok * N_QKV + head * 64 + 32 + fq * 8);
              float a[8] = {bflo(q0.x), bfhi(q0.x), bflo(q0.y), bfhi(q0.y), bflo(q0.z), bfhi(q0.z), bflo(q0.w), bfhi(q0.w)};
              float c[8] = {bflo(q1.x), bfhi(q1.x), bflo(q1.y), bfhi(q1.y), bflo(q1.z), bfhi(q1.z), bflo(q1.w), bfhi(q1.w)};
              float ss = 0.f;
#pragma unroll
              for (int e = 0; e < 8; ++e) ss += a[e] * a[e] + c[e] * c[e];
              ss += __shfl_xor(ss, 16); ss += __shfl_xor(ss, 32);
              const float rstd = 0.125f / sqrtf(ss * (1.f / 64.f) + EPS);
              const f32x4 w0 = *(const f32x4*)(qnw + fq * 8), w1 = *(const f32x4*)(qnw + fq * 8 + 4), w2 = *(const f32x4*)(qnw + 32 + fq * 8), w3 = *(const f32x4*)(qnw + 32 + fq * 8 + 4);
              u32x4 o0, o1;
              o0.x = pk2(a[0] * rstd * w0.x, a[1] * rstd * w0.y); o0.y = pk2(a[2] * rstd * w0.z, a[3] * rstd * w0.w); o0.z = pk2(a[4] * rstd * w1.x, a[5] * rstd * w1.y); o0.w = pk2(a[6] * rstd * w1.z, a[7] * rstd * w1.w);
              o1.x = pk2(c[0] * rstd * w2.x, c[1] * rstd * w2.y); o1.y = pk2(c[2] * rstd * w2.z, c[3] * rstd * w2.w); o1.z = pk2(c[4] * rstd * w3.x, c[5] * rstd * w3.y); o1.w = pk2(c[6] * rstd * w3.z, c[7] * rstd * w3.w);
              qf[0] = __builtin_bit_cast(bf16x8, o0); qf[1] = __builtin_bit_cast(bf16x8, o1); }
            const int kstart = 32 * (qt >> 1);
            f32x4 sa[10]; float mx = sink;
#pragma unroll
            for (int kt = 0; kt < 10; ++kt) { sa[kt] = (f32x4){0.f, 0.f, 0.f, 0.f};
#pragma unroll
                for (int kk = 0; kk < 2; ++kk) { const bf16x8 kf = *(const LAS bf16x8*)(lds + KSB + (kstart + 16 * kt + fr) * KSTR + kk * 64 + fq * 16); sa[kt] = mfma16(kf, qf[kk], sa[kt]); }
#pragma unroll
                for (int i = 0; i < 4; ++i) { const int r = kstart + 16 * kt + 4 * fq + i, rel = 128 + qi - r;
                    const bool valid = (rel >= 0) && (rel < 128) && (r + 128 * j >= 128);
                    sa[kt][i] = valid ? sa[kt][i] : -INFINITY; mx = fmaxf(mx, sa[kt][i]); } }
            mx = fmaxf(mx, __shfl_xor(mx, 16)); mx = fmaxf(mx, __shfl_xor(mx, 32));
            float sum = 0.f; unsigned pw[10][2];
#pragma unroll
            for (int kt = 0; kt < 10; ++kt) { float p[4];
#pragma unroll
                for (int i = 0; i < 4; ++i) { p[i] = __expf(sa[kt][i] - mx); sum += p[i]; }
                pw[kt][0] = pk2(p[0], p[1]); pw[kt][1] = pk2(p[2], p[3]); }
            sum += __shfl_xor(sum, 16); sum += __shfl_xor(sum, 32);
            const float inv = 1.f / (sum + __expf(sink - mx));
#pragma unroll
            for (int dt = 0; dt < 4; ++dt) { f32x4 oa = (f32x4){0.f, 0.f, 0.f, 0.f};
#pragma unroll
                for (int kb = 0; kb < 5; ++kb) { const LAS unsigned char* vp = lds + VTB + (16 * dt + fr) * VSTR + (kstart + 32 * kb + 4 * fq) * 2;
                    const s16x4 lo = *(const LAS s16x4*)vp, hi = *(const LAS s16x4*)(vp + 32);
                    const bf16x8 vf = (bf16x8){lo[0], lo[1], lo[2], lo[3], hi[0], hi[1], hi[2], hi[3]};
                    const u32x4 pu = (u32x4){pw[2 * kb][0], pw[2 * kb][1], pw[2 * kb + 1][0], pw[2 * kb + 1][1]};
                    oa = mfma16(vf, __builtin_bit_cast(bf16x8, pu), oa); }
                oa = oa * inv;
                u32x2 w; w.x = pk2(oa.x, oa.y); w.y = pk2(oa.z, oa.w);
                *(u32x2*)(O + tok * D + head * 64 + 16 * dt + 4 * fq) = w; }
        }
        __syncthreads();
    }
}

struct Params { const float* in[23]; float* out; unsigned char* ws; int ph_lo, ph_hi; };
constexpr int N_PHASES = 18;

__global__ void __launch_bounds__(NTHR, 2) fwd_kernel(Params P) {
    extern __shared__ __attribute__((aligned(16))) unsigned char lds_raw[];
    LAS unsigned char* lds = (LAS unsigned char*)lds_raw;
    cg::grid_group grid = cg::this_grid();
    const int tid = threadIdx.x, lane = tid & 63, wave = __builtin_amdgcn_readfirstlane(tid >> 6);
    const int G = gridDim.x, gw = blockIdx.x * NWAVES + wave, NGW = G * NWAVES, gtid = blockIdx.x * NTHR + tid, gthreads = G * NTHR;
    unsigned char* ws = P.ws;
    const float* x = P.in[0]; const float* cvec = P.in[1];
    float* mod0 = (float*)(ws + WS_MOD); float* mod1 = mod0 + 8 * MODW;
    float* Gg = (float*)(ws + WS_G); float* SS = (float*)(ws + WS_SS);
    bf16* WG = (bf16*)(ws + WS_WG); bf16* WA = (bf16*)(ws + WS_W_A); bf16* WB = (bf16*)(ws + WS_W_B); bf16* WC = (bf16*)(ws + WS_W_C); bf16* WD = (bf16*)(ws + WS_W_D);
    bf16* A2 = (bf16*)(ws + WS_A2); bf16* XN = (bf16*)(ws + WS_XN); bf16* U = (bf16*)(ws + WS_U); bf16* QKVO = (bf16*)(ws + WS_QKVO);
    bf16* Hb = (bf16*)(ws + WS_H); bf16* HS = (bf16*)(ws + WS_HS);
    float* out = P.out;
    const int lo = P.ph_lo, hi = P.ph_hi;
#define IN(k) (lo <= (k) && (k) < hi)
#define SEAM(k) do { if (IN(k) && IN((k) + 1)) grid.sync(); } while (0)

    if (IN(0)) {
        if (blockIdx.x < 192) { const int w = blockIdx.x, l = w / 96, r = w % 96;
            mod_task(cvec, l ? P.in[12] : P.in[2], l ? P.in[13] : P.in[3], l ? mod1 : mod0, r >> 1, r & 1, lds, tid, wave, lane); }
        const ConvJob j0{P.in[4], WA, 2048, LD_WIN, N_IN, 32 * (N_IN / 32)}, j1{P.in[7], WB, 2048, 2048, 2048, 32 * 64}, j2{P.in[8], WC, 2048, FF2, FF2, 32 * (FF2 / 32)}, j3{P.in[11], WD, FF, 2048, 2048, (FF / 64) * 64};
        convert_weights(j0, j1, j2, j3, lds, gw, NGW, wave, lane);
        for (int e = gtid; e < 16 * 2048; e += gthreads) { const int g = e >> 11, k = e & 2047; WG[e] = (bf16)f2bf(P.in[4][(size_t)k * LD_WIN + N_IN + g]); }
        __syncthreads();
    }
    SEAM(0);
    if (IN(1)) norm_mod_rows(x, XN, mod0 + 0 * 2048, mod0 + 1 * 2048, gw, NGW, lane);
    SEAM(1);
    if (IN(2)) {
        pg8::Gemm g{XN, WA, M, N_IN, D}; pg8::StaticOrder S; S.init(M, N_IN, G, (int)blockIdx.x);
        pg8::EpiBf16<0> E{QKVO, N_IN, nullptr, 1024, 1024, 0.08838834764831845f};
        pg8::gemm_phase<pg8::EpiBf16<0>, pg8::StaticOrder, true, true>(lds, g, S, E);
        gate_gemm(XN, WG, P.in[5], Gg, wave, lane);
    }
    SEAM(2);
    if (IN(3)) mlstm_phase(lds, QKVO, Gg, Hb, SS, tid, wave, lane);
    SEAM(3);
    if (IN(4)) headnorm_rows(Hb, QKVO, SS, P.in[6], HS, gw, NGW, lane);
    SEAM(4);
    if (IN(5)) {
        pg8::Gemm g{HS, WB, M, D, D}; pg8::StaticOrder S; S.init(M, D, G, (int)blockIdx.x);
        pg8::EpiResGate E{x, out, mod0 + 2 * 2048, MODW};
        pg8::gemm_phase<pg8::EpiResGate, pg8::StaticOrder, true, true>(lds, g, S, E);
    }
    SEAM(5);
    if (IN(6)) norm_mod_rows(out, XN, mod0 + 3 * 2048, mod0 + 4 * 2048, gw, NGW, lane);
    SEAM(6);
    if (IN(7)) {
        pg8::Gemm g{XN, WC, M, FF2, D}; pg8::StaticOrder S; S.init(M, FF2, G, (int)blockIdx.x);
        pg8::EpiBf16<0> E{U, FF2, nullptr, 0, 0, 1.f};
        pg8::gemm_phase<pg8::EpiBf16<0>, pg8::StaticOrder, true, true>(lds, g, S, E);
    }
    SEAM(7);
    if (IN(8)) conv_pass(U, A2, P.in[9], P.in[10], gtid, gthreads);
    SEAM(8);
    if (IN(9)) {
        pg8::Gemm g{A2, WD, M, D, FF}; pg8::StaticOrder S; S.init(M, D, G, (int)blockIdx.x);
        pg8::EpiResGate E{out, out, mod0 + 5 * 2048, MODW};
        pg8::gemm_phase<pg8::EpiResGate, pg8::StaticOrder, true, true>(lds, g, S, E);
    }
    SEAM(9);
    if (IN(10)) {
        const ConvJob j0{P.in[14], WA, 2048, N_QKV, N_QKV, 32 * (N_QKV / 32)}, j1{P.in[18], WB, 2048, 2048, 2048, 32 * 64}, j2{P.in[19], WC, 2048, FF2, FF2, 32 * (FF2 / 32)}, j3{P.in[22], WD, FF, 2048, 2048, (FF / 64) * 64};
        convert_weights(j0, j1, j2, j3, lds, gw, NGW, wave, lane);
        norm_mod_rows(out, XN, mod1 + 0 * 2048, mod1 + 1 * 2048, gw, NGW, lane);
    }
    SEAM(10);
    if (IN(11)) {
        pg8::Gemm g{XN, WA, M, N_QKV, D}; pg8::StaticOrder S; S.init(M, N_QKV, G, (int)blockIdx.x);
        pg8::EpiBf16<0> E{QKVO, N_QKV, nullptr, 0, 0, 1.f};
        pg8::gemm_phase<pg8::EpiBf16<0>, pg8::StaticOrder, true, true>(lds, g, S, E);
    }
    SEAM(11);
    if (IN(12)) swa_phase(lds, QKVO, P.in[15], P.in[16], P.in[17], Hb, tid, wave, lane);
    SEAM(12);
    if (IN(13)) {
        pg8::Gemm g{Hb, WB, M, D, D}; pg8::StaticOrder S; S.init(M, D, G, (int)blockIdx.x);
        pg8::EpiResGate E{out, out, mod1 + 2 * 2048, MODW};
        pg8::gemm_phase<pg8::EpiResGate, pg8::StaticOrder, true, true>(lds, g, S, E);
    }
    SEAM(13);
    if (IN(14)) norm_mod_rows(out, XN, mod1 + 3 * 2048, mod1 + 4 * 2048, gw, NGW, lane);
    SEAM(14);
    if (IN(15)) {
        pg8::Gemm g{XN, WC, M, FF2, D}; pg8::StaticOrder S; S.init(M, FF2, G, (int)blockIdx.x);
        pg8::EpiBf16<0> E{U, FF2, nullptr, 0, 0, 1.f};
        pg8::gemm_phase<pg8::EpiBf16<0>, pg8::StaticOrder, true, true>(lds, g, S, E);
    }
    SEAM(15);
    if (IN(16)) conv_pass(U, A2, P.in[20], P.in[21], gtid, gthreads);
    SEAM(16);
    if (IN(17)) {
        pg8::Gemm g{A2, WD, M, D, FF}; pg8::StaticOrder S; S.init(M, D, G, (int)blockIdx.x);
        pg8::EpiResGate E{out, out, mod1 + 5 * 2048, MODW};
        pg8::gemm_phase<pg8::EpiResGate, pg8::StaticOrder, true, true>(lds, g, S, E);
    }
#undef IN
#undef SEAM
}

#ifndef ONE_LAUNCH
#define ONE_LAUNCH 1
#endif
extern "C" void kernel_launch(void* const* d_in, const int* in_sizes, int n_in, void* d_out, int out_size, void* d_ws, size_t ws_size, hipStream_t stream) {
    static int grid = 0;
    if (grid == 0) {
        if (n_in != 23 || in_sizes[0] != M * D || out_size != M * D || ws_size < WS_END) { fprintf(stderr, "kernel_launch: unexpected shapes (n_in %d, ws %zu); nothing launched\n", n_in, ws_size); grid = -1; return; }
        int dev = 0, cus = 0, per_cu = 0;
        if (hipGetDevice(&dev) != hipSuccess || hipDeviceGetAttribute(&cus, hipDeviceAttributeMultiprocessorCount, dev) != hipSuccess) { grid = -1; return; }
        if (hipFuncSetAttribute((const void*)fwd_kernel, hipFuncAttributeMaxDynamicSharedMemorySize, LDS_BYTES) != hipSuccess) { fprintf(stderr, "kernel_launch: hipFuncSetAttribute failed\n"); grid = -1; return; }
        if (hipOccupancyMaxActiveBlocksPerMultiprocessor(&per_cu, (const void*)fwd_kernel, NTHR, LDS_BYTES) != hipSuccess || per_cu < 1) { fprintf(stderr, "kernel_launch: occupancy query says %d\n", per_cu); per_cu = 1; }
        (void)hipGetLastError();
        grid = cus;
    }
    if (grid < 0) return;
    (void)hipMemsetAsync((char*)d_ws + WS_MOD, 0, MOD_BYTES, stream);
    Params p{};
    for (int i = 0; i < 23; ++i) p.in[i] = (const float*)d_in[i];
    p.out = (float*)d_out; p.ws = (unsigned char*)d_ws;
#if ONE_LAUNCH
    p.ph_lo = 0; p.ph_hi = N_PHASES;
    void* args[] = {&p};
    hipError_t e = hipLaunchCooperativeKernel((const void*)fwd_kernel, dim3(grid), dim3(NTHR), args, LDS_BYTES, stream);
    if (e != hipSuccess) fprintf(stderr, "cooperative launch failed: %s (grid %d)\n", hipGetErrorString(e), grid);
#else
    for (int ph = 0; ph < N_PHASES; ++ph) { p.ph_lo = ph; p.ph_hi = ph + 1; hipLaunchKernelGGL(fwd_kernel, dim3(grid), dim3(NTHR), LDS_BYTES, stream, p); }
#endif
}
```

```cpp
#include <hip/hip_runtime.h>
#include <hip/hip_cooperative_groups.h>
#include <cstdio>
#include <cstdint>
#include <cmath>
namespace cg = cooperative_groups;
namespace pg8 {
#define PG8_LAS __attribute__((address_space(3)))
typedef unsigned short bf16_t;
typedef short bf16x8 __attribute__((ext_vector_type(8)));
typedef float f32x4 __attribute__((ext_vector_type(4)));
typedef unsigned u32x4 __attribute__((ext_vector_type(4)));
constexpr int BM = 256, BK = 64, HALF = 128, HTB = HALF * BK * 2  , STAGE_BYTES = 8 * HTB, NXCD = 8, WGM = 8;

__host__ __device__ __forceinline__ int lds_byte(int r, int c) { const int st = (r >> 4) * 2 + (c >> 5), rr = r & 15, cc = c & 31, ob = rr * 64 + cc * 2; return st * 1024 + (ob ^ (((ob >> 9) & 1) << 5)); }
__host__ __device__ __forceinline__ void stage_rc(int b, int& R, int& C) { const int st = b / 1024, sb = b % 1024, swz = sb ^ (((sb >> 9) & 1) << 5); R = (st >> 1) * 16 + swz / 64; C = (st & 1) * 32 + (swz % 64) / 2; }
__host__ __device__ __forceinline__ int perm32(int rho) { const int n = rho >> 4, i = rho & 15; return 8 * (i >> 2) + 4 * n + (i & 3); }

struct Unit { int pm, pn; };
struct Gemm { const bf16_t* A; const bf16_t* Bt; int M, N, K; };

struct StaticOrder {
    int nM, nN, nwg, G, c;
    __host__ __device__ void init(int M, int N, int G_, int c_) { nM = M / BM; nN = N / BM; nwg = nM * nN; G = G_; c = c_; }
    __host__ __device__ bool next(int i, Unit& u) const {
        const long L = (long)i * G + c; if (L >= nwg) return false;
        int wgid = (int)L; { const int q = nwg / NXCD, r = nwg % NXCD, xcd = wgid % NXCD, off = wgid / NXCD; wgid = (xcd < r ? xcd * (q + 1) : r * (q + 1) + (xcd - r) * q) + off; }
        const int nig = WGM * nN, gid = wgid / nig, fm = gid * WGM, gsz = (nM - fm) < WGM ? (nM - fm) : WGM;
        u.pm = fm + ((wgid % nig) % gsz); u.pn = (wgid % nig) / gsz; return true;
    }
    __device__ __forceinline__ void a_ready(const Unit&) const {}
    __device__ __forceinline__ void done(const Unit&) const {}
};

__device__ __forceinline__ unsigned cvt_pk_bf16(float lo, float hi) { unsigned r; asm volatile("v_cvt_pk_bf16_f32 %0, %1, %2" : "=v"(r) : "v"(lo), "v"(hi)); return r; }
typedef float f32x2 __attribute__((ext_vector_type(2)));
__device__ __forceinline__ f32x2 gelu_pk(f32x2 v) {
    const f32x2 av = __builtin_elementwise_abs(v), d = av * 0.2316418882f + 1.0f;
    f32x2 t; t.x = __builtin_amdgcn_rcpf(d.x); t.y = __builtin_amdgcn_rcpf(d.y);
    f32x2 q = t * 0.5307027145f + (-0.7265760135f); q = q * t + 0.7107068705f; q = q * t + (-0.142248368f); q = q * t + 0.127414796f; q = q * t;
    const f32x2 s = (v * v) * (-0.72134752044f);
    f32x2 e; e.x = __builtin_amdgcn_exp2f(s.x); e.y = __builtin_amdgcn_exp2f(s.y);
    const f32x2 m = v * (q * e), r = v - m;
    f32x2 o; o.x = v.x < 0.f ? m.x : r.x; o.y = v.y < 0.f ? m.y : r.y; return o;
}

template <int ACT  > struct EpiBf16 {
    static constexpr bool PERM = true, AFTER_DRAIN = false; static_assert(ACT == 0 || ACT == 1, "EpiBf16: ACT is 0 (none) or 1 (gelu_pk)");
    bf16_t* O; int ldc; const float* bias; int split_cols; size_t split_stride; float scale0;
    __device__ __forceinline__ void operator()(const f32x4 (&acc)[2][2][4][2], const Unit& u, int wr, int wc, int fr, int fq) const {
        const int row0 = u.pm * BM + wr * 64 + fr; int colt = u.pn * BM; bf16_t* base = O;
        float sc = 1.f; if (split_cols) { const int t = colt / split_cols; base += (size_t)t * split_stride; colt -= t * split_cols; if (t == 0) sc = scale0; }
        const int col0 = colt + wc * 32 + 8 * fq, bcol0 = u.pn * BM + wc * 32 + 8 * fq;
        f32x4 bv[2][2];
#pragma unroll
        for (int bj = 0; bj < 2; ++bj)
#pragma unroll
            for (int n = 0; n < 2; ++n) bv[bj][n] = bias ? *(const f32x4*)(bias + bcol0 + bj * HALF + 4 * n) : (f32x4){0.f, 0.f, 0.f, 0.f};
#pragma unroll
        for (int ai = 0; ai < 2; ++ai)
#pragma unroll
            for (int m = 0; m < 4; ++m) { bf16_t* rowp = base + (size_t)(row0 + ai * HALF + m * 16) * ldc + col0;
#pragma unroll
                for (int bj = 0; bj < 2; ++bj) { f32x4 v0 = acc[ai][bj][m][0] + bv[bj][0], v1 = acc[ai][bj][m][1] + bv[bj][1];
                    if (ACT == 1) { f32x2 a = gelu_pk((f32x2){v0[0], v0[1]}), b = gelu_pk((f32x2){v0[2], v0[3]}), c = gelu_pk((f32x2){v1[0], v1[1]}), d = gelu_pk((f32x2){v1[2], v1[3]});
                        v0 = (f32x4){a.x, a.y, b.x, b.y}; v1 = (f32x4){c.x, c.y, d.x, d.y}; }
                    v0 = v0 * sc; v1 = v1 * sc; u32x4 w; w.x = cvt_pk_bf16(v0[0], v0[1]); w.y = cvt_pk_bf16(v0[2], v0[3]); w.z = cvt_pk_bf16(v1[0], v1[1]); w.w = cvt_pk_bf16(v1[2], v1[3]);
                    *(u32x4*)(rowp + bj * HALF) = w; } }
    }
};
__device__ __forceinline__ void epi_res_gate_body(const f32x4 (&acc)[2][2][4][2], const float* __restrict__ res, float* __restrict__ out, const float* __restrict__ gate, int row0, int col0) {
#pragma unroll
    for (int bj = 0; bj < 2; ++bj)
#pragma unroll
        for (int n = 0; n < 2; ++n) { const int cc = col0 + bj * HALF + n * 16; const f32x4 gv = *(const f32x4*)(gate + cc);
            f32x4 r[2][4];
#pragma unroll
            for (int ai = 0; ai < 2; ++ai)
#pragma unroll
                for (int m = 0; m < 4; ++m) r[ai][m] = *(const f32x4*)(res + (size_t)(row0 + ai * HALF + m * 16) * 2048 + cc);
#pragma unroll
            for (int ai = 0; ai < 2; ++ai)
#pragma unroll
                for (int m = 0; m < 4; ++m) *(f32x4*)(out + (size_t)(row0 + ai * HALF + m * 16) * 2048 + cc) = r[ai][m] + gv * acc[ai][bj][m][n];
            asm volatile("" ::: "memory"); }
}
struct EpiResGate {
    static constexpr bool PERM = false, AFTER_DRAIN = false;
    const float* res; float* out; const float* gate; int gstride;
    __device__ __forceinline__ void operator()(const f32x4 (&acc)[2][2][4][2], const Unit& u, int wr, int wc, int fr_, int fq_) const {
        int fr = fr_, fq = fq_; asm volatile("" : "+v"(fr), "+v"(fq));
        epi_res_gate_body(acc, res, out, gate + (size_t)((u.pm * BM) >> 11) * gstride, u.pm * BM + wr * 64 + fr, u.pn * BM + wc * 32 + 4 * fq);
    }
};
__device__ __forceinline__ float dpp_prev(float older, float cur, int which) {
    const int o = __builtin_bit_cast(int, older), c = __builtin_bit_cast(int, cur);
    if (which == 1) { const int r = __builtin_amdgcn_update_dpp(0, o, 0x121, 0xf, 0xf, false); return __builtin_bit_cast(float, __builtin_amdgcn_update_dpp(r, c, 0x111, 0xf, 0xf, false)); }
    const int r = __builtin_amdgcn_update_dpp(0, o, 0x122, 0xf, 0xf, false); return __builtin_bit_cast(float, __builtin_amdgcn_update_dpp(r, c, 0x112, 0xf, 0xf, false));
}
struct EpiConvAct {
    static constexpr bool PERM = true, AFTER_DRAIN = false;
    bf16_t* A2; const float* cw; const float* cb; float* SBUF; PG8_LAS unsigned char* halo;
    __device__ __forceinline__ void operator()(const f32x4 (&acc)[2][2][4][2], const Unit& u, int wr, int wc, int fr, int fq) const {
        constexpr int FF = 5632, FF2 = 11264;
        const int cl0 = wc * 32 + 8 * fq;
        PG8_LAS float* hl = (PG8_LAS float*)halo;
        if (fr >= 14) {
#pragma unroll
            for (int ai = 0; ai < 2; ++ai)
#pragma unroll
                for (int bj = 0; bj < 2; ++bj)
#pragma unroll
                    for (int n = 0; n < 2; ++n) *(PG8_LAS f32x4*)(hl + ((((2 * ai + wr) * 2 + (fr - 14)) * 2 + bj) * 128 + cl0 + 4 * n)) = acc[ai][bj][3][n];
            if (wr == 1) {
#pragma unroll
                for (int bj = 0; bj < 2; ++bj)
#pragma unroll
                    for (int n = 0; n < 2; ++n) *(f32x4*)(SBUF + (size_t)(u.pm * 4 + 2 + fr - 14) * FF2 + bj * FF + u.pn * 128 + cl0 + 4 * n) = acc[1][bj][3][n];
            }
        }
        if (wr == 0 && fr < 2) {
#pragma unroll
            for (int bj = 0; bj < 2; ++bj)
#pragma unroll
                for (int n = 0; n < 2; ++n) *(f32x4*)(SBUF + (size_t)(u.pm * 4 + fr) * FF2 + bj * FF + u.pn * 128 + cl0 + 4 * n) = acc[0][bj][0][n];
        }
        asm volatile("s_waitcnt lgkmcnt(0)" ::: "memory"); __builtin_amdgcn_s_barrier(); asm volatile("" ::: "memory");
        u32x4 keep[2][4];
#pragma unroll
        for (int n = 0; n < 2; ++n) {
            const int c = u.pn * 128 + cl0 + 4 * n;
            const f32x4 wg0 = *(const f32x4*)(cw + c), wg1 = *(const f32x4*)(cw + FF2 + c), wg2 = *(const f32x4*)(cw + 2 * FF2 + c), bg = *(const f32x4*)(cb + c);
            const f32x4 wv0 = *(const f32x4*)(cw + FF + c), wv1 = *(const f32x4*)(cw + FF2 + FF + c), wv2 = *(const f32x4*)(cw + 2 * FF2 + FF + c), bv = *(const f32x4*)(cb + FF + c);
#pragma unroll
            for (int ai = 0; ai < 2; ++ai) {
                const int s = 2 * ai + wr;
                f32x4 xhg = (f32x4){0.f, 0.f, 0.f, 0.f}, xhv = (f32x4){0.f, 0.f, 0.f, 0.f};
                if (s > 0) { const int hr = (fr == 15) ? 1 : 0;
                    xhg = *(const PG8_LAS f32x4*)(hl + ((((s - 1) * 2 + hr) * 2 + 0) * 128 + cl0 + 4 * n)); xhv = *(const PG8_LAS f32x4*)(hl + ((((s - 1) * 2 + hr) * 2 + 1) * 128 + cl0 + 4 * n)); }
#pragma unroll
                for (int m = 0; m < 4; ++m) {
                    const f32x4 xg = acc[ai][0][m][n], xv = acc[ai][1][m][n];
                    const f32x4 pg = (m == 0) ? xhg : acc[ai][0][m == 0 ? 0 : m - 1][n], pv = (m == 0) ? xhv : acc[ai][1][m == 0 ? 0 : m - 1][n];
                    float o[4];
#pragma unroll
                    for (int e = 0; e < 4; ++e) {
                        const float g = wg0[e] * dpp_prev(pg[e], xg[e], 2) + wg1[e] * dpp_prev(pg[e], xg[e], 1) + wg2[e] * xg[e] + bg[e];
                        const float v = wv0[e] * dpp_prev(pv[e], xv[e], 2) + wv1[e] * dpp_prev(pv[e], xv[e], 1) + wv2[e] * xv[e] + bv[e];
                        o[e] = g * __builtin_amdgcn_rcpf(1.f + __expf(-g)) * v; }
                    const unsigned w0 = cvt_pk_bf16(o[0], o[1]), w1 = cvt_pk_bf16(o[2], o[3]);
                    if (n == 0) { keep[ai][m].x = w0; keep[ai][m].y = w1; }
                    else { keep[ai][m].z = w0; keep[ai][m].w = w1;
                        *(u32x4*)(A2 + (size_t)(u.pm * BM + ai * HALF + wr * 64 + m * 16 + fr) * FF + u.pn * 128 + cl0) = keep[ai][m]; }
                }
            }
        }
    }
};
template <class Epi, class Sched, bool ALIGN_EPI = false, bool SP2 = false>
__device__ __forceinline__ void gemm_phase(PG8_LAS unsigned char* lds, const Gemm g, const Sched& S, const Epi& E) {
    const int tid = threadIdx.x, wid = __builtin_amdgcn_readfirstlane(tid >> 6), lane = tid & 63, wr = wid >> 2, wc = wid & 3, fr = lane & 15, fq = lane >> 4;
    const int K = g.K, nt = K / BK;
    unsigned voffA[2], voffB[2];
#pragma unroll
    for (int i = 0; i < 2; ++i) { int R, C; stage_rc(tid * 16 + i * 8192, R, C); const int Rb = Epi::PERM ? ((R & ~31) + perm32(R & 31)) : R;
        voffA[i] = (unsigned)(R * K + C) * 2u; voffB[i] = (unsigned)(Rb * K + C) * 2u; }
    const size_t kstep = (size_t)(BK * 2);
    const size_t hstep = (size_t)HALF * K * 2;
    const size_t tstep = 2 * hstep;
    const unsigned ldsw = (unsigned)wid * 1024u;
    const int aoff = lds_byte(wr * 64 + fr, fq * 8), boff = lds_byte(wc * 32 + fr, fq * 8);
#define PG8_SA(b, h) (((b) * 2 + (h)) * HTB)
#define PG8_SB(b, h) ((4 + (b) * 2 + (h)) * HTB)
#define PG8_STAGE(bufoff, gbase, voff) do { _Pragma("unroll") for (int _i = 0; _i < 2; ++_i) \
        __builtin_amdgcn_global_load_lds((const unsigned*)((const char*)(gbase) + (voff)[_i]), (PG8_LAS unsigned*)(lds + (bufoff) + ldsw + _i * 8192), 16, 0, 0); } while (0)
#define PG8_LDA(dst, b, h) do { _Pragma("unroll") for (int m = 0; m < 4; ++m) _Pragma("unroll") for (int k = 0; k < 2; ++k) dst[m][k] = *(const PG8_LAS bf16x8*)(lds + PG8_SA(b, h) + aoff + m * 2048 + k * 1024); } while (0)
#define PG8_LDB(dst, b, h) do { _Pragma("unroll") for (int n = 0; n < 2; ++n) _Pragma("unroll") for (int k = 0; k < 2; ++k) dst[n][k] = *(const PG8_LAS bf16x8*)(lds + PG8_SB(b, h) + boff + n * 2048 + k * 1024); } while (0)
#define PG8_MMA(ai, bj, At, Bt) do { __builtin_amdgcn_s_setprio(1); _Pragma("unroll") for (int m = 0; m < 4; ++m) _Pragma("unroll") for (int n = 0; n < 2; ++n) _Pragma("unroll") for (int k = 0; k < 2; ++k) \
        acc[ai][bj][m][n] = __builtin_amdgcn_mfma_f32_16x16x32_bf16(Bt[n][k], At[m][k], acc[ai][bj][m][n], 0, 0, 0); __builtin_amdgcn_s_setprio(0); } while (0)
#define PG8_WAIT_V(n) asm volatile("s_waitcnt vmcnt(" #n ")" ::: "memory")
#define PG8_WAIT_L(n) asm volatile("s_waitcnt lgkmcnt(" #n ")" ::: "memory")
#define PG8_BAR __builtin_amdgcn_s_barrier()
#define PG8_SCHED __builtin_amdgcn_sched_barrier(0)
    Unit cur, nxt; int ui = 0;
    if (!S.next(0, cur)) return;
    f32x4 acc[2][2][4][2];
#pragma unroll
    for (int a = 0; a < 2; ++a)
#pragma unroll
        for (int b = 0; b < 2; ++b)
#pragma unroll
            for (int m = 0; m < 4; ++m)
#pragma unroll
                for (int n = 0; n < 2; ++n) acc[a][b][m][n] = (f32x4){0.f, 0.f, 0.f, 0.f};
    bf16x8 At[4][2], B0[2][2], B1[2][2];
    const char* cA = (const char*)g.A + (size_t)cur.pm * tstep; const char* cB = (const char*)g.Bt + (size_t)cur.pn * tstep;
    S.a_ready(cur);
    if constexpr (SP2) {
        PG8_STAGE(PG8_SB(0, 0), cB, voffB); PG8_STAGE(PG8_SB(0, 1), cB + hstep, voffB); PG8_STAGE(PG8_SA(0, 0), cA, voffA); PG8_STAGE(PG8_SA(0, 1), cA + hstep, voffA);
        if (wr == 1) PG8_BAR;
        PG8_WAIT_V(2); PG8_BAR;
        PG8_STAGE(PG8_SB(1, 0), cB + kstep, voffB); PG8_STAGE(PG8_SA(1, 0), cA + kstep, voffA); PG8_STAGE(PG8_SB(1, 1), cB + hstep + kstep, voffB);
        PG8_WAIT_V(6); PG8_BAR;
    } else {
        PG8_STAGE(PG8_SB(0, 0), cB, voffB); PG8_STAGE(PG8_SA(0, 0), cA, voffA); PG8_STAGE(PG8_SB(0, 1), cB + hstep, voffB); PG8_STAGE(PG8_SA(0, 1), cA + hstep, voffA);
        if (wr == 1) PG8_BAR;
        PG8_WAIT_V(4); PG8_BAR;
        PG8_STAGE(PG8_SB(1, 0), cB + kstep, voffB); PG8_STAGE(PG8_SA(1, 0), cA + kstep, voffA); PG8_STAGE(PG8_SB(1, 1), cB + hstep + kstep, voffB);
        PG8_WAIT_V(6); PG8_BAR;
    }
    for (;;) {
        const bool has_next = S.next(ui + 1, nxt);
        const char* nA = has_next ? (const char*)g.A + (size_t)nxt.pm * tstep : cA; const char* nB = has_next ? (const char*)g.Bt + (size_t)nxt.pn * tstep : cB;
        for (int t = 0; t < nt; t += 2) {
            const bool last = (t == nt - 2);
            const char* a1 = cA + (size_t)(t + 1) * kstep;
            const char* a2 = last ? nA : cA + (size_t)(t + 2) * kstep; const char* b2 = last ? nB : cB + (size_t)(t + 2) * kstep;
            const char* a3 = a2 + kstep; const char* b3 = b2 + kstep;
            if (last && has_next) S.a_ready(nxt);
            if constexpr (SP2) {
            PG8_LDB(B0, 0, 0); PG8_LDB(B1, 0, 1); PG8_SCHED; PG8_LDA(At, 0, 0); PG8_STAGE(PG8_SA(1, 1), a1 + hstep, voffA);
            PG8_WAIT_V(8); PG8_WAIT_L(0); PG8_BAR; PG8_MMA(0, 0, At, B0); PG8_MMA(0, 1, At, B1); PG8_BAR; PG8_SCHED;
            PG8_LDA(At, 0, 1); PG8_STAGE(PG8_SB(0, 0), b2, voffB); PG8_STAGE(PG8_SB(0, 1), b2 + hstep, voffB); PG8_STAGE(PG8_SA(0, 0), a2, voffA);
            PG8_WAIT_V(8); PG8_WAIT_L(0); PG8_BAR; PG8_MMA(1, 0, At, B0); PG8_MMA(1, 1, At, B1); PG8_BAR; PG8_SCHED;
            PG8_LDB(B0, 1, 0); PG8_LDB(B1, 1, 1); PG8_SCHED; PG8_LDA(At, 1, 0); PG8_STAGE(PG8_SA(0, 1), a2 + hstep, voffA);
            PG8_WAIT_V(8); PG8_WAIT_L(0); PG8_BAR; PG8_MMA(0, 0, At, B0); PG8_MMA(0, 1, At, B1); PG8_BAR; PG8_SCHED;
            PG8_LDA(At, 1, 1); PG8_STAGE(PG8_SB(1, 0), b3, voffB); PG8_STAGE(PG8_SB(1, 1), b3 + hstep, voffB); PG8_STAGE(PG8_SA(1, 0), a3, voffA);
            PG8_WAIT_V(8); PG8_WAIT_L(0); PG8_BAR; PG8_MMA(1, 0, At, B0); PG8_MMA(1, 1, At, B1); PG8_BAR; PG8_SCHED;
            } else {
            PG8_LDB(B0, 0, 0); PG8_SCHED; PG8_LDA(At, 0, 0); PG8_STAGE(PG8_SA(1, 1), a1 + hstep, voffA);
            PG8_WAIT_L(8); PG8_BAR; PG8_WAIT_L(0); PG8_MMA(0, 0, At, B0); PG8_BAR; PG8_SCHED;
            PG8_LDB(B1, 0, 1); PG8_STAGE(PG8_SB(0, 0), b2, voffB);
            PG8_BAR; PG8_WAIT_L(0); PG8_MMA(0, 1, At, B1); PG8_BAR;
            PG8_LDA(At, 0, 1); PG8_STAGE(PG8_SA(0, 0), a2, voffA);
            PG8_BAR; PG8_WAIT_L(0); PG8_MMA(1, 0, At, B0); PG8_BAR; PG8_SCHED;
            PG8_STAGE(PG8_SB(0, 1), b2 + hstep, voffB);
            PG8_WAIT_V(6); PG8_BAR; PG8_MMA(1, 1, At, B1); PG8_BAR;
            PG8_LDB(B0, 1, 0); PG8_SCHED; PG8_LDA(At, 1, 0); PG8_STAGE(PG8_SA(0, 1), a2 + hstep, voffA);
            PG8_WAIT_L(8); PG8_BAR; PG8_WAIT_L(0); PG8_MMA(0, 0, At, B0); PG8_BAR; PG8_SCHED;
            PG8_LDB(B1, 1, 1); PG8_STAGE(PG8_SB(1, 0), b3, voffB);
            PG8_BAR; PG8_WAIT_L(0); PG8_MMA(0, 1, At, B1); PG8_BAR;
            PG8_LDA(At, 1, 1); PG8_STAGE(PG8_SA(1, 0), a3, voffA);
            PG8_BAR; PG8_WAIT_L(0); PG8_MMA(1, 0, At, B0); PG8_BAR; PG8_SCHED;
            PG8_STAGE(PG8_SB(1, 1), b3 + hstep, voffB);
            PG8_WAIT_V(6); PG8_BAR; PG8_MMA(1, 1, At, B1); PG8_BAR;
            }
        }
        if constexpr (ALIGN_EPI) { if (wr == 0) PG8_BAR; }
        if constexpr (!Epi::AFTER_DRAIN) { E(acc, cur, wr, wc, fr, fq); S.done(cur); }
        if (!has_next) break;
#pragma unroll
        for (int a = 0; a < 2; ++a)
#pragma unroll
            for (int b = 0; b < 2; ++b)
#pragma unroll
                for (int m = 0; m < 4; ++m)
#pragma unroll
                    for (int n = 0; n < 2; ++n) acc[a][b][m][n] = (f32x4){0.f, 0.f, 0.f, 0.f};
        cur = nxt; cA = nA; cB = nB; ++ui;
        if constexpr (ALIGN_EPI) { if (wr == 1) PG8_BAR; }
    }
    PG8_WAIT_V(0);
    if constexpr (!ALIGN_EPI) { if (wr == 0) PG8_BAR; }
    PG8_BAR;
    if constexpr (Epi::AFTER_DRAIN) { E.fused(acc, cur, wr, wc, fr, fq, lds, wid, lane); S.done(cur); }
#undef PG8_SA
#undef PG8_SB
#undef PG8_STAGE
#undef PG8_LDA
#undef PG8_LDB
#undef PG8_MMA
#undef PG8_WAIT_V
#undef PG8_WAIT_L
#undef PG8_BAR
#undef PG8_SCHED
}
}

#define LAS __attribute__((address_space(3)))
typedef unsigned short bf16;
typedef float f32x4 __attribute__((ext_vector_type(4)));
typedef short bf16x8 __attribute__((ext_vector_type(8)));
typedef short s16x4 __attribute__((ext_vector_type(4)));
typedef unsigned u32x4 __attribute__((ext_vector_type(4)));
typedef unsigned u32x2 __attribute__((ext_vector_type(2)));

constexpr int NWAVES = 8, NTHR = 512;
constexpr int M = 16384, D = 2048, SEQ = 2048;
constexpr int N_IN = 6144, LD_WIN = 6160, FF = 5632, FF2 = 11264, N_QKV = 2560, MODW = 12288;
constexpr float EPS = 1e-6f;
constexpr int LDS_BYTES = 147456;

constexpr size_t MiB = 1u << 20;
constexpr size_t WS_MOD = 0;
constexpr size_t MOD_BYTES = 2 * 8 * 12288 * 4;
constexpr size_t WS_BAR = 896 * 1024;
constexpr size_t CTL_ZERO_BYTES = 1u << 20;
constexpr size_t WS_G = 1 * MiB;
constexpr size_t WS_SS = 2 * MiB;
constexpr size_t WS_WG = 6 * MiB;
constexpr size_t WS_W_A = 8 * MiB;
constexpr size_t WS_W_B = 32 * MiB;
constexpr size_t WS_W_C = 40 * MiB;
constexpr size_t WS_W_D = 84 * MiB;
constexpr size_t WS_A2 = 112 * MiB;
constexpr size_t WS_QKVO = 112 * MiB;
constexpr size_t WS_H = 304 * MiB;
constexpr size_t WS_HS = 368 * MiB;
constexpr size_t WS_XN = 432 * MiB;
constexpr size_t WS_SB = 496 * MiB;
constexpr size_t WS_W1_A = 512 * MiB, WS_W1_B = 524 * MiB, WS_W1_C = 532 * MiB, WS_W1_D = 576 * MiB;
constexpr size_t WS_GBAR = 920 * 1024;
constexpr size_t WS_END = 600 * MiB;

#define LDS_WAIT() asm volatile("s_waitcnt lgkmcnt(0)" ::: "memory")
__device__ __forceinline__ unsigned f2bf(float f) { unsigned u = __builtin_bit_cast(unsigned, f); return (u + 0x7fffu + ((u >> 16) & 1u)) >> 16; }
__device__ __forceinline__ unsigned pk2(float lo, float hi) { return pg8::cvt_pk_bf16(lo, hi); }
__device__ __forceinline__ float bflo(unsigned w) { return __builtin_bit_cast(float, w << 16); }
__device__ __forceinline__ float bfhi(unsigned w) { return __builtin_bit_cast(float, w & 0xffff0000u); }
__device__ __forceinline__ float wave_sum(float v) {
#pragma unroll
    for (int o = 1; o < 64; o <<= 1) v += __shfl_xor(v, o);
    return v;
}
__device__ __forceinline__ f32x4 mfma16(bf16x8 a, bf16x8 b, f32x4 c) { return __builtin_amdgcn_mfma_f32_16x16x32_bf16(a, b, c, 0, 0, 0); }

__device__ __forceinline__ void transpose_item(const float* W, int K, int ldw, int ncols, bf16* WT, LAS float* scr, int item, int lane, bool upperm) {
    const int nblk = ncols / 32, kb = item / nblk, nb = item % nblk, k0 = 64 * kb, n0 = 32 * nb;
    int r0 = n0; if (upperm) { const int bj = n0 >= FF ? 1 : 0, rem = n0 - bj * FF; r0 = (rem >> 7) * 256 + bj * 128 + (rem & 127); }
#pragma unroll 8
    for (int i = 0; i < 32; ++i) { const int kk = 2 * i + (lane >> 5); scr[kk * 33 + (lane & 31)] = W[(size_t)(k0 + kk) * ldw + n0 + (lane & 31)]; }
    LDS_WAIT(); asm volatile("" ::: "memory");
    const int c = lane & 7;
#pragma unroll
    for (int j = 0; j < 4; ++j) { const int n = (lane >> 3) + 8 * j; const LAS float* s = scr + (8 * c) * 33 + n;
        u32x4 o; o.x = pk2(s[0 * 33], s[1 * 33]); o.y = pk2(s[2 * 33], s[3 * 33]); o.z = pk2(s[4 * 33], s[5 * 33]); o.w = pk2(s[6 * 33], s[7 * 33]);
        *(u32x4*)(WT + (size_t)(r0 + n) * K + k0 + 8 * c) = o; }
    LDS_WAIT(); asm volatile("" ::: "memory");
}
struct ConvJob { const float* W; bf16* WT; int K, ldw, ncols, items; };
__device__ __forceinline__ void convert_weights(const ConvJob& j0, const ConvJob& j1, const ConvJob& j2, const ConvJob& j3, LAS unsigned char* lds, int slot0, int nsl, int T, int wave, int lane) {
    LAS float* scr = (LAS float*)(lds + wave * 16384);
    const int total = j0.items + j1.items + j2.items + j3.items;
    for (int sl = 0; sl < nsl; ++sl)
    for (int it = slot0 + sl; it < total; it += T) {
        int r = it;
        if (r < j0.items) { transpose_item(j0.W, j0.K, j0.ldw, j0.ncols, j0.WT, scr, r, lane, false); continue; } r -= j0.items;
        if (r < j1.items) { transpose_item(j1.W, j1.K, j1.ldw, j1.ncols, j1.WT, scr, r, lane, false); continue; } r -= j1.items;
        if (r < j2.items) { transpose_item(j2.W, j2.K, j2.ldw, j2.ncols, j2.WT, scr, r, lane, true); continue; } r -= j2.items;
        transpose_item(j3.W, j3.K, j3.ldw, j3.ncols, j3.WT, scr, r, lane, false);
    }
}
__device__ __forceinline__ void mod_task(const float* c, const float* wmod, const float* bmod, float* modl, int cg, int kh, LAS unsigned char* lds, int tid, int wave, int lane) {
    LAS float* sl = (LAS float*)lds;
    LAS float* red = (LAS float*)(lds + 32768);
    for (int e = tid; e < 8192; e += NTHR) { const int kk = e >> 3, b = e & 7; const float cv = c[b * 2048 + kh * 1024 + kk]; sl[e] = cv / (1.f + __expf(-cv)); }
    __syncthreads();
    const float* wp = wmod + (size_t)(kh * 1024 + wave * 128) * MODW + cg * 256 + lane * 4;
    f32x4 acc[8];
#pragma unroll
    for (int b = 0; b < 8; ++b) acc[b] = (f32x4){0.f, 0.f, 0.f, 0.f};
#pragma unroll 4
    for (int k = 0; k < 128; ++k) {
        const f32x4 wv = *(const f32x4*)(wp + (size_t)k * MODW);
        const LAS f32x4* sp = (const LAS f32x4*)(sl + (wave * 128 + k) * 8);
        const f32x4 s0 = sp[0], s1 = sp[1];
        acc[0] += s0.x * wv; acc[1] += s0.y * wv; acc[2] += s0.z * wv; acc[3] += s0.w * wv;
        acc[4] += s1.x * wv; acc[5] += s1.y * wv; acc[6] += s1.z * wv; acc[7] += s1.w * wv;
    }
#pragma unroll
    for (int b = 0; b < 8; ++b) *(LAS f32x4*)(red + (wave * 8 + b) * 256 + lane * 4) = acc[b];
    __syncthreads();
    for (int o = tid; o < 2048; o += NTHR) { const int b = o >> 8, col = o & 255; float s = 0.f;
#pragma unroll
        for (int w = 0; w < 8; ++w) s += red[(w * 8 + b) * 256 + col];
        if (kh == 0) s += bmod[cg * 256 + col];
        atomicAdd(modl + (size_t)b * MODW + cg * 256 + col, s); }
    __syncthreads();
}

__device__ __forceinline__ void norm_mod_rows(const float* X, bf16* XN, const float* shift, const float* scale, int r0, int lane) {
    const int b = r0 >> 11; const float* sh = shift + (size_t)b * MODW; const float* sc = scale + (size_t)b * MODW;
    f32x4 a0[4], a1[4], h0[4], h1[4];
#pragma unroll
    for (int j = 0; j < 4; ++j) { const int col = 8 * lane + 512 * j; a0[j] = *(const f32x4*)(sc + col) + 1.f; a1[j] = *(const f32x4*)(sc + col + 4) + 1.f; h0[j] = *(const f32x4*)(sh + col); h1[j] = *(const f32x4*)(sh + col + 4); }
    f32x4 v[4][2], nx[4][2];
#pragma unroll
    for (int j = 0; j < 4; ++j) { const f32x4* p = (const f32x4*)(X + (size_t)r0 * D + 8 * lane + 512 * j); v[j][0] = p[0]; v[j][1] = p[1]; }
    for (int r = r0; r < r0 + 2048; r += 256) {
        const int rn = (r + 256 < r0 + 2048) ? r + 256 : r;
#pragma unroll
        for (int j = 0; j < 4; ++j) { const f32x4* p = (const f32x4*)(X + (size_t)rn * D + 8 * lane + 512 * j); nx[j][0] = p[0]; nx[j][1] = p[1]; }
        float s = 0.f;
#pragma unroll
        for (int j = 0; j < 4; ++j) {
            s += (v[j][0].x * v[j][0].x + v[j][0].y * v[j][0].y) + (v[j][0].z * v[j][0].z + v[j][0].w * v[j][0].w);
            s += (v[j][1].x * v[j][1].x + v[j][1].y * v[j][1].y) + (v[j][1].z * v[j][1].z + v[j][1].w * v[j][1].w); }
        s = wave_sum(s); const float rstd = 1.f / sqrtf(s * (1.f / 2048.f) + EPS);
#pragma unroll
        for (int j = 0; j < 4; ++j) { const int col = 8 * lane + 512 * j;
            const f32x4 o0 = v[j][0] * rstd * a0[j] + h0[j], o1 = v[j][1] * rstd * a1[j] + h1[j];
            u32x4 w; w.x = pk2(o0.x, o0.y); w.y = pk2(o0.z, o0.w); w.z = pk2(o1.x, o1.y); w.w = pk2(o1.z, o1.w);
            *(u32x4*)(XN + (size_t)r * D + col) = w; }
#pragma unroll
        for (int j = 0; j < 4; ++j) { v[j][0] = nx[j][0]; v[j][1] = nx[j][1]; }
    }
}
__device__ __forceinline__ void headnorm_rows(const bf16* H, const bf16* QKVO, const float* SS, const float* hnorm, bf16* HS, int r0, int lane) {
    for (int r = r0; r < r0 + 2048; r += 256) {
#pragma unroll
        for (int j = 0; j < 4; ++j) { const int col = 8 * lane + 512 * j, head = col >> 8;
            const f32x4 s0 = *(const f32x4*)(SS + (size_t)r * 64 + head * 8), s1 = *(const f32x4*)(SS + (size_t)r * 64 + head * 8 + 4);
            const float ssum = ((s0.x + s0.y) + (s0.z + s0.w)) + ((s1.x + s1.y) + (s1.z + s1.w));
            const float rstd = 1.f / sqrtf(ssum * (1.f / 256.f) + EPS);
            const u32x4 hv = *(const u32x4*)(H + (size_t)r * D + col), ov = *(const u32x4*)(QKVO + (size_t)r * N_IN + 4096 + col);
            const f32x4 n0 = *(const f32x4*)(hnorm + col), n1 = *(const f32x4*)(hnorm + col + 4);
            float hh[8] = {bflo(hv.x), bfhi(hv.x), bflo(hv.y), bfhi(hv.y), bflo(hv.z), bfhi(hv.z), bflo(hv.w), bfhi(hv.w)};
            float oo[8] = {bflo(ov.x), bfhi(ov.x), bflo(ov.y), bfhi(ov.y), bflo(ov.z), bfhi(ov.z), bflo(ov.w), bfhi(ov.w)};
            float nn[8] = {n0.x, n0.y, n0.z, n0.w, n1.x, n1.y, n1.z, n1.w};
            float rr[8];
#pragma unroll
            for (int e = 0; e < 8; ++e) rr[e] = hh[e] * rstd * nn[e] / (1.f + __expf(-oo[e]));
            u32x4 w; w.x = pk2(rr[0], rr[1]); w.y = pk2(rr[2], rr[3]); w.z = pk2(rr[4], rr[5]); w.w = pk2(rr[6], rr[7]);
            *(u32x4*)(HS + (size_t)r * D + col) = w; }
    }
}
__device__ __forceinline__ void conv_pass(const bf16* U, bf16* A2, const float* cw, const float* cb, int gtid, int gthreads) {
    for (int task = gtid; task < 704 * 512; task += gthreads) {
        const int cgp = task % 704, rr = task / 704, c0 = cgp * 8, r0 = rr * 32;
        float wg[3][8], wv[3][8], bg[8], bv[8];
#pragma unroll
        for (int j = 0; j < 3; ++j)
#pragma unroll
            for (int e = 0; e < 8; ++e) { wg[j][e] = cw[j * FF2 + c0 + e]; wv[j][e] = cw[j * FF2 + FF + c0 + e]; }
#pragma unroll
        for (int e = 0; e < 8; ++e) { bg[e] = cb[c0 + e]; bv[e] = cb[FF + c0 + e]; }
        float g2[8], g1[8], v2[8], v1[8];
        if ((r0 & 2047) == 0) {
#pragma unroll
            for (int e = 0; e < 8; ++e) { g2[e] = 0.f; g1[e] = 0.f; v2[e] = 0.f; v1[e] = 0.f; }
        } else {
            const u32x4 a = *(const u32x4*)(U + (size_t)(r0 - 2) * FF2 + c0), b = *(const u32x4*)(U + (size_t)(r0 - 1) * FF2 + c0);
            const u32x4 c = *(const u32x4*)(U + (size_t)(r0 - 2) * FF2 + FF + c0), d = *(const u32x4*)(U + (size_t)(r0 - 1) * FF2 + FF + c0);
            g2[0] = bflo(a.x); g2[1] = bfhi(a.x); g2[2] = bflo(a.y); g2[3] = bfhi(a.y); g2[4] = bflo(a.z); g2[5] = bfhi(a.z); g2[6] = bflo(a.w); g2[7] = bfhi(a.w);
            g1[0] = bflo(b.x); g1[1] = bfhi(b.x); g1[2] = bflo(b.y); g1[3] = bfhi(b.y); g1[4] = bflo(b.z); g1[5] = bfhi(b.z); g1[6] = bflo(b.w); g1[7] = bfhi(b.w);
            v2[0] = bflo(c.x); v2[1] = bfhi(c.x); v2[2] = bflo(c.y); v2[3] = bfhi(c.y); v2[4] = bflo(c.z); v2[5] = bfhi(c.z); v2[6] = bflo(c.w); v2[7] = bfhi(c.w);
            v1[0] = bflo(d.x); v1[1] = bfhi(d.x); v1[2] = bflo(d.y); v1[3] = bfhi(d.y); v1[4] = bflo(d.z); v1[5] = bfhi(d.z); v1[6] = bflo(d.w); v1[7] = bfhi(d.w);
        }
#pragma unroll 2
        for (int i = 0; i < 32; ++i) {
            const size_t r = (size_t)(r0 + i);
            const u32x4 a = *(const u32x4*)(U + r * FF2 + c0), c = *(const u32x4*)(U + r * FF2 + FF + c0);
            float g0[8] = {bflo(a.x), bfhi(a.x), bflo(a.y), bfhi(a.y), bflo(a.z), bfhi(a.z), bflo(a.w), bfhi(a.w)};
            float v0[8] = {bflo(c.x), bfhi(c.x), bflo(c.y), bfhi(c.y), bflo(c.z), bfhi(c.z), bflo(c.w), bfhi(c.w)};
            float o[8];
#pragma unroll
            for (int e = 0; e < 8; ++e) {
                const float g = wg[0][e] * g2[e] + wg[1][e] * g1[e] + wg[2][e] * g0[e] + bg[e];
                const float v = wv[0][e] * v2[e] + wv[1][e] * v1[e] + wv[2][e] * v0[e] + bv[e];
                o[e] = g / (1.f + __expf(-g)) * v;
                g2[e] = g1[e]; g1[e] = g0[e]; v2[e] = v1[e]; v1[e] = v0[e];
            }
            u32x4 w; w.x = pk2(o[0], o[1]); w.y = pk2(o[2], o[3]); w.z = pk2(o[4], o[5]); w.w = pk2(o[6], o[7]);
            *(u32x4*)(A2 + r * FF + c0) = w;
        }
    }
}

__device__ __forceinline__ void gate_gemm(const bf16* XN, const bf16* WG, const float* gbias, float* G, int wave, int lane) {
    if (wave >= 4) return;
    const int fr = lane & 15, fq = lane >> 4;
    { const int task = ((int)blockIdx.x & 7) * 128 + ((int)blockIdx.x >> 3) * 4 + wave;
        const int r0 = task * 16;
        const bf16* ap = WG + (size_t)fr * D + fq * 8; const bf16* bp = XN + (size_t)(r0 + fr) * D + fq * 8;
        f32x4 acc = (f32x4){0.f, 0.f, 0.f, 0.f};
#pragma unroll 8
        for (int kk = 0; kk < 64; ++kk) { const bf16x8 a = *(const bf16x8*)(ap + kk * 32), b = *(const bf16x8*)(bp + kk * 32); acc = mfma16(a, b, acc); }
        const f32x4 bi = *(const f32x4*)(gbias + 4 * fq);
        f32x4 o;
#pragma unroll
        for (int i = 0; i < 4; ++i) { float g = 15.f * tanhf((acc[i] + bi[i]) * (1.f / 15.f));
            if (fq >= 2) g = fminf(g, 0.f) - log1pf(__expf(-fabsf(g)));
            o[i] = g; }
        *(f32x4*)(G + (size_t)(r0 + fr) * 16 + 4 * fq) = o;
    }
}

struct CvItem { const float* src; bf16* dst; int K; int valid; };
constexpr int CV_ITEMS_TOTAL = 2048 + 11264 + 5632 + 2560 + 2048 + 11264 + 5632;
constexpr int CV_ROWB = 72, CV_TILE = 64 * CV_ROWB;
__device__ __forceinline__ void cv_decode(const float* W0, const float* W1, const float* W2, const float* W3, const float* W4, const float* W5, const float* W6, bf16* T0, bf16* T1, bf16* T2, bf16* T3, bf16* T4, bf16* T5, bf16* T6, int it, int lane, CvItem& I, int& ldw) {
    int j, r = it;
    if (r < 2048) j = 0; else if ((r -= 2048) < 11264) j = 1; else if ((r -= 11264) < 5632) j = 2; else if ((r -= 5632) < 2560) j = 3; else if ((r -= 2560) < 2048) j = 4; else if ((r -= 2048) < 11264) j = 5; else { r -= 11264; j = 6; }
    const int ncols = (j == 1 || j == 5) ? FF2 : (j == 3 ? N_QKV : 2048), K = (j == 2 || j == 6) ? FF : 2048;
    const int nblk = ncols / 32, kb = r / nblk, nb = r % nblk, k0 = 64 * kb, n0 = 32 * nb;
    int r0 = n0; if (j == 1 || j == 5) { const int bj = n0 >= FF ? 1 : 0, rem = n0 - bj * FF; r0 = (rem >> 7) * 256 + bj * 128 + (rem & 127); }
    const float* W = j == 0 ? W0 : j == 1 ? W1 : j == 2 ? W2 : j == 3 ? W3 : j == 4 ? W4 : j == 5 ? W5 : W6;
    bf16* WT = j == 0 ? T0 : j == 1 ? T1 : j == 2 ? T2 : j == 3 ? T3 : j == 4 ? T4 : j == 5 ? T5 : T6;
    ldw = ncols; I.K = K; I.valid = 1;
    I.src = W + (size_t)(k0 + (lane >> 3)) * ncols + n0 + 4 * (lane & 7);
    I.dst = WT + (size_t)r0 * K + k0;
}
__device__ __forceinline__ void mlstm_phase(LAS unsigned char* lds, const bf16* QKVO, const float* G, bf16* H, float* SS, const float* W0, const float* W1, const float* W2, const float* W3, const float* W4, const float* W5, const float* W6, bf16* T0, bf16* T1, bf16* T2, bf16* T3, bf16* T4, bf16* T5, bf16* T6, int gw, int NGW, int tid, int wave, int lane) {
    constexpr int CVS = 109312;
    constexpr int QS = 0, KS = 17408, KT = 34816, VT = 53248, CT = 62464, NS = 79872, GB = 80384, GA = GB + 8192, GC = GA + 8192, RS = 272, TS = 144;
    const int fr = lane & 15, fq = lane >> 4, tt = wave >> 1, vh = wave & 1;
    {
        const int b = (int)blockIdx.x & 7, h = (int)blockIdx.x >> 5, vs = ((int)blockIdx.x >> 3) & 3;
        const size_t rowb = (size_t)b * SEQ;
        for (int e = tid; e < 17408 / 4; e += NTHR) ((LAS unsigned*)(lds + CT))[e] = 0u;
        if (tid < 128) ((LAS float*)(lds + NS))[tid] = 0.f;
#pragma unroll
        for (int cc = 0; cc < 4; ++cc) { const int c = wave + 8 * cc; const size_t gi = (rowb + 64 * c + lane) * 16;
            const float ig = G[gi + h]; float bsum = G[gi + 8 + h];
#pragma unroll
            for (int off = 1; off < 64; off <<= 1) { const float t = __shfl_up(bsum, off); if (lane >= off) bsum += t; }
            const float a = ig - bsum; float cm = a;
#pragma unroll
            for (int off = 1; off < 64; off <<= 1) { const float t = __shfl_up(cm, off); if (lane >= off) cm = fmaxf(cm, t); }
            ((LAS float*)(lds + GB))[64 * c + lane] = bsum; ((LAS float*)(lds + GA))[64 * c + lane] = a; ((LAS float*)(lds + GC))[64 * c + lane] = cm; }
        f32x4 Cacc[4];
#pragma unroll
        for (int vt = 0; vt < 4; ++vt) Cacc[vt] = (f32x4){0.f, 0.f, 0.f, 0.f};
        float m_run = 0.f;
        u32x4 rq[2], rk[2], rv;
        const int vrow = tid >> 3, vc = tid & 7;
#define ML_LOAD(c) do { \
        _Pragma("unroll") for (int i_ = 0; i_ < 2; ++i_) { const int p_ = tid + 512 * i_, prow_ = p_ >> 4, pc_ = p_ & 15; \
            const bf16* src_ = QKVO + (rowb + 64 * (c) + prow_) * N_IN + h * 128 + pc_ * 8; rq[i_] = *(const u32x4*)src_; rk[i_] = *(const u32x4*)(src_ + 1024); } \
        rv = *(const u32x4*)(QKVO + (rowb + 64 * (c) + vrow) * N_IN + 2048 + h * 256 + vs * 64 + vc * 8); } while (0)
        ML_LOAD(0);
        __syncthreads();
        for (int c = 0; c < 32; ++c) {
            const LAS float* gb = (const LAS float*)(lds + GB) + 64 * c; const LAS float* ga = (const LAS float*)(lds + GA) + 64 * c; const LAS float* gc = (const LAS float*)(lds + GC) + 64 * c;
            const float M63 = fmaxf(m_run, gc[63]), total = gb[63];
            const float decay = __expf(m_run - M63);
            { const float wl = __expf(ga[lane] - M63);
#pragma unroll
              for (int i = 0; i < 2; ++i) { const int p = tid + 512 * i, prow = p >> 4, pc = p & 15;
                const float w = __shfl(wl, prow);
                *(LAS u32x4*)(lds + QS + prow * RS + pc * 16) = rq[i]; *(LAS u32x4*)(lds + KS + prow * RS + pc * 16) = rk[i];
                const unsigned kw[4] = {rk[i].x, rk[i].y, rk[i].z, rk[i].w};
                const int ko = ((((prow >> 3) ^ pc) & 7) << 4) + (prow & 7) * 2;
#pragma unroll
                for (int e = 0; e < 4; ++e) { const unsigned pk = pk2(bflo(kw[e]) * w, bfhi(kw[e]) * w);
                    *(LAS unsigned short*)(lds + KT + (pc * 8 + 2 * e) * TS + ko) = (unsigned short)(pk & 0xffffu);
                    *(LAS unsigned short*)(lds + KT + (pc * 8 + 2 * e + 1) * TS + ko) = (unsigned short)(pk >> 16); } } }
            { const unsigned vw[4] = {rv.x, rv.y, rv.z, rv.w};
              const int vo = ((((vrow >> 3) ^ vc) & 7) << 4) + (vrow & 7) * 2;
#pragma unroll
                for (int e = 0; e < 4; ++e) {
                    *(LAS unsigned short*)(lds + VT + (vc * 8 + 2 * e) * TS + vo) = (unsigned short)(vw[e] & 0xffffu);
                    *(LAS unsigned short*)(lds + VT + (vc * 8 + 2 * e + 1) * TS + vo) = (unsigned short)(vw[e] >> 16); } }
            __syncthreads();
            if (c + 1 < 32) ML_LOAD(c + 1);
            CvItem ci; ci.valid = 0; ci.K = 0; ci.src = nullptr; ci.dst = nullptr; int cldw = 0; f32x4 cv[8];
            { const int it = gw + c * NGW; if (it < CV_ITEMS_TOTAL) cv_decode(W0, W1, W2, W3, W4, W5, W6, T0, T1, T2, T3, T4, T5, T6, it, lane, ci, cldw); }
            if (ci.valid) {
#pragma unroll
                for (int i = 0; i < 8; ++i) cv[i] = *(const f32x4*)(ci.src + (size_t)(8 * i) * cldw); }
            const int trow = 16 * tt + fr;
            const float Mt_r = fmaxf(m_run, gc[trow]), wi_r = __expf(m_run - Mt_r), emt_r = __expf(-(gb[trow] + Mt_r));
            bf16x8 qf[4];
#pragma unroll
            for (int kk = 0; kk < 4; ++kk) qf[kk] = *(const LAS bf16x8*)(lds + QS + trow * RS + kk * 64 + fq * 16);
            float rs = 0.f; unsigned pw[4][2];
#pragma unroll
            for (int st = 0; st < 4; ++st) { f32x4 sa = (f32x4){0.f, 0.f, 0.f, 0.f};
#pragma unroll
                for (int kk = 0; kk < 4; ++kk) { const bf16x8 kf = *(const LAS bf16x8*)(lds + KS + (16 * st + fr) * RS + kk * 64 + fq * 16); sa = mfma16(kf, qf[kk], sa); }
                const f32x4 as4 = *(const LAS f32x4*)(ga + 16 * st + 4 * fq);
                float pv[4];
#pragma unroll
                for (int i = 0; i < 4; ++i) { const int s = 16 * st + 4 * fq + i;
                    const float dw = (s <= trow) ? __expf(as4[i] - Mt_r) : 0.f; pv[i] = sa[i] * dw; rs += pv[i]; }
                pw[st][0] = pk2(pv[0], pv[1]); pw[st][1] = pk2(pv[2], pv[3]); }
            rs += __shfl_xor(rs, 16); rs += __shfl_xor(rs, 32);
            float qn = 0.f;
#pragma unroll
            for (int kk = 0; kk < 4; ++kk) { const LAS f32x4* np = (const LAS f32x4*)(lds + NS + (32 * kk + 8 * fq) * 4); const f32x4 n0 = np[0], n1 = np[1];
                const u32x4 qw = __builtin_bit_cast(u32x4, qf[kk]);
                qn += bflo(qw.x) * n0.x + bfhi(qw.x) * n0.y + bflo(qw.y) * n0.z + bfhi(qw.y) * n0.w + bflo(qw.z) * n1.x + bfhi(qw.z) * n1.y + bflo(qw.w) * n1.z + bfhi(qw.w) * n1.w; }
            qn += __shfl_xor(qn, 16); qn += __shfl_xor(qn, 32);
            const float den = wi_r * qn + rs, inv = 1.f / fmaxf(fabsf(den), emt_r);
            float ssq = 0.f;
#pragma unroll
            for (int j = 0; j < 2; ++j) { const int vt = 2 * vh + j; f32x4 o1 = (f32x4){0.f, 0.f, 0.f, 0.f}, o2 = (f32x4){0.f, 0.f, 0.f, 0.f};
#pragma unroll
                for (int kb = 0; kb < 2; ++kb) { const int gv = (2 * vt + (fr >> 3)) & 7; const LAS unsigned char* vr = lds + VT + (16 * vt + fr) * TS + (fq & 1) * 8;
                    const s16x4 lo = *(const LAS s16x4*)(vr + (((4 * kb + (fq >> 1)) ^ gv) << 4)), hi = *(const LAS s16x4*)(vr + (((4 * kb + 2 + (fq >> 1)) ^ gv) << 4));
                    const bf16x8 vf = (bf16x8){lo[0], lo[1], lo[2], lo[3], hi[0], hi[1], hi[2], hi[3]};
                    const u32x4 pu = (u32x4){pw[2 * kb][0], pw[2 * kb][1], pw[2 * kb + 1][0], pw[2 * kb + 1][1]};
                    o1 = mfma16(vf, __builtin_bit_cast(bf16x8, pu), o1); }
#pragma unroll
                for (int kk = 0; kk < 4; ++kk) { const bf16x8 cf = *(const LAS bf16x8*)(lds + CT + (16 * vt + fr) * RS + kk * 64 + fq * 16); o2 = mfma16(cf, qf[kk], o2); }
                const f32x4 hv = (o2 * wi_r + o1) * inv;
                ssq += (hv.x * hv.x + hv.y * hv.y) + (hv.z * hv.z + hv.w * hv.w);
                u32x2 w; w.x = pk2(hv.x, hv.y); w.y = pk2(hv.z, hv.w);
                *(u32x2*)(H + (rowb + 64 * c + trow) * D + h * 256 + vs * 64 + 16 * vt + 4 * fq) = w; }
            ssq += __shfl_xor(ssq, 16); ssq += __shfl_xor(ssq, 32);
            if (fq == 0) SS[(rowb + 64 * c + trow) * 64 + h * 8 + vs * 2 + vh] = ssq;
#pragma unroll
            for (int vt = 0; vt < 4; ++vt) Cacc[vt] = Cacc[vt] * decay;
#pragma unroll
            for (int kb = 0; kb < 2; ++kb) { const bf16x8 ktf = *(const LAS bf16x8*)(lds + KT + (16 * wave + fr) * TS + (((4 * kb + fq) ^ ((2 * wave + (fr >> 3)) & 7)) << 4));
#pragma unroll
                for (int vt = 0; vt < 4; ++vt) { const bf16x8 vtf = *(const LAS bf16x8*)(lds + VT + (16 * vt + fr) * TS + (((4 * kb + fq) ^ ((2 * vt + (fr >> 3)) & 7)) << 4)); Cacc[vt] = mfma16(ktf, vtf, Cacc[vt]); } }
            float ksum = 0.f;
            if (tid < 128) {
#pragma unroll
                for (int e8 = 0; e8 < 8; ++e8) { const u32x4 w = *(const LAS u32x4*)(lds + KT + tid * TS + e8 * 16);
                    ksum += ((bflo(w.x) + bfhi(w.x)) + (bflo(w.y) + bfhi(w.y))) + ((bflo(w.z) + bfhi(w.z)) + (bflo(w.w) + bfhi(w.w))); } }
            __syncthreads();
#pragma unroll
            for (int vt = 0; vt < 4; ++vt) { u32x2 w; w.x = pk2(Cacc[vt].x, Cacc[vt].y); w.y = pk2(Cacc[vt].z, Cacc[vt].w);
                *(LAS u32x2*)(lds + CT + (16 * vt + fr) * RS + (16 * wave + 4 * fq) * 2) = w; }
            if (tid < 128) { LAS float* ns = (LAS float*)(lds + NS); ns[tid] = decay * ns[tid] + ksum; }
            if (ci.valid) { LAS unsigned char* sc = lds + CVS + wave * CV_TILE;
#pragma unroll
                for (int i = 0; i < 8; ++i) { u32x2 w; w.x = pk2(cv[i].x, cv[i].y); w.y = pk2(cv[i].z, cv[i].w);
                    *(LAS u32x2*)(sc + (8 * i + (lane >> 3)) * CV_ROWB + (lane & 7) * 8) = w; }
                LDS_WAIT(); asm volatile("" ::: "memory");
                const int c8 = lane & 7;
#pragma unroll
                for (int j = 0; j < 4; ++j) { const int n = (lane >> 3) + 8 * j; const LAS unsigned char* s = sc + (8 * c8) * CV_ROWB + n * 2;
                    u32x4 o;
                    o.x = (unsigned)*(const LAS unsigned short*)(s + 0 * CV_ROWB) | ((unsigned)*(const LAS unsigned short*)(s + 1 * CV_ROWB) << 16);
                    o.y = (unsigned)*(const LAS unsigned short*)(s + 2 * CV_ROWB) | ((unsigned)*(const LAS unsigned short*)(s + 3 * CV_ROWB) << 16);
                    o.z = (unsigned)*(const LAS unsigned short*)(s + 4 * CV_ROWB) | ((unsigned)*(const LAS unsigned short*)(s + 5 * CV_ROWB) << 16);
                    o.w = (unsigned)*(const LAS unsigned short*)(s + 6 * CV_ROWB) | ((unsigned)*(const LAS unsigned short*)(s + 7 * CV_ROWB) << 16);
                    *(u32x4*)(ci.dst + (size_t)n * ci.K + 8 * c8) = o; }
                LDS_WAIT(); asm volatile("" ::: "memory"); }
            m_run = total + M63;
        }
#undef ML_LOAD
        __syncthreads();
    }
}

__device__ __forceinline__ void swa_phase(LAS unsigned char* lds, const bf16* QKV, const float* qnw, const float* knw, const float* sinks, bf16* O, int tid, int wave, int lane) {
    constexpr int KSB = 0, KSTR = 144, VTB = 36864, VSTR = 528;
    const int fr = lane & 15, fq = lane >> 4;
    for (int ui = 0; ui < 2; ++ui) {
        const int b = (int)blockIdx.x & 7, uu = ((int)blockIdx.x >> 3) + 32 * ui, kvh = uu >> 4, j = uu & 15;
        const size_t rowb = (size_t)b * SEQ;
#pragma unroll
        for (int i = 0; i < 4; ++i) { const int idx = tid + 512 * i, r = idx >> 3, ch = idx & 7; const int pos = 128 * (j - 1) + r;
            u32x4 kv = (u32x4){0u, 0u, 0u, 0u}, vv = (u32x4){0u, 0u, 0u, 0u};
            if (pos >= 0) { const bf16* sp = QKV + (rowb + pos) * N_QKV + 2048 + kvh * 64 + ch * 8; kv = *(const u32x4*)sp; vv = *(const u32x4*)(sp + 256); }
            float kf[8] = {bflo(kv.x), bfhi(kv.x), bflo(kv.y), bfhi(kv.y), bflo(kv.z), bfhi(kv.z), bflo(kv.w), bfhi(kv.w)};
            float ss = 0.f;
#pragma unroll
            for (int e2 = 0; e2 < 8; ++e2) ss += kf[e2] * kf[e2];
            ss += __shfl_xor(ss, 1); ss += __shfl_xor(ss, 2); ss += __shfl_xor(ss, 4);
            const float rstd = 1.f / sqrtf(ss * (1.f / 64.f) + EPS);
            const f32x4 w0 = *(const f32x4*)(knw + ch * 8), w1 = *(const f32x4*)(knw + ch * 8 + 4);
            u32x4 ko; ko.x = pk2(kf[0] * rstd * w0.x, kf[1] * rstd * w0.y); ko.y = pk2(kf[2] * rstd * w0.z, kf[3] * rstd * w0.w);
            ko.z = pk2(kf[4] * rstd * w1.x, kf[5] * rstd * w1.y); ko.w = pk2(kf[6] * rstd * w1.z, kf[7] * rstd * w1.w);
            *(LAS u32x4*)(lds + KSB + r * KSTR + ch * 16) = ko;
            const unsigned vw[4] = {vv.x, vv.y, vv.z, vv.w};
            const int vo = (((r >> 3) ^ ch) << 4) + (r & 7) * 2;
#pragma unroll
            for (int e2 = 0; e2 < 4; ++e2) {
                *(LAS unsigned short*)(lds + VTB + (ch * 8 + 2 * e2) * VSTR + vo) = (unsigned short)(vw[e2] & 0xffffu);
                *(LAS unsigned short*)(lds + VTB + (ch * 8 + 2 * e2 + 1) * VSTR + vo) = (unsigned short)(vw[e2] >> 16); } }
        __syncthreads();
        const int head = kvh * 8 + wave; const float sink = sinks[head];
        u32x4 qraw[2][2];
#pragma unroll
        for (int h2 = 0; h2 < 2; ++h2) { const bf16* qp = QKV + (rowb + 128 * j + 16 * h2 + fr) * N_QKV + head * 64 + fq * 8; qraw[h2][0] = *(const u32x4*)qp; qraw[h2][1] = *(const u32x4*)(qp + 32); }
        const f32x4 w0 = *(const f32x4*)(qnw + fq * 8), w1 = *(const f32x4*)(qnw + fq * 8 + 4), w2 = *(const f32x4*)(qnw + 32 + fq * 8), w3 = *(const f32x4*)(qnw + 32 + fq * 8 + 4);
        for (int qa = 0; qa < 4; ++qa) {
            const int kstart = 32 * qa;
            bf16x8 qf[2][2]; int qi[2]; size_t tok[2];
#pragma unroll
            for (int h2 = 0; h2 < 2; ++h2) { qi[h2] = 16 * (2 * qa + h2) + fr; tok[h2] = rowb + 128 * j + qi[h2];
                const u32x4 q0 = qraw[h2][0], q1 = qraw[h2][1];
                if (qa + 1 < 4) { const bf16* qp = QKV + (tok[h2] + 32) * N_QKV + head * 64 + fq * 8; qraw[h2][0] = *(const u32x4*)qp; qraw[h2][1] = *(const u32x4*)(qp + 32); }
                float a[8] = {bflo(q0.x), bfhi(q0.x), bflo(q0.y), bfhi(q0.y), bflo(q0.z), bfhi(q0.z), bflo(q0.w), bfhi(q0.w)};
                float c[8] = {bflo(q1.x), bfhi(q1.x), bflo(q1.y), bfhi(q1.y), bflo(q1.z), bfhi(q1.z), bflo(q1.w), bfhi(q1.w)};
                float ss = 0.f;
#pragma unroll
                for (int e2 = 0; e2 < 8; ++e2) ss += a[e2] * a[e2] + c[e2] * c[e2];
                ss += __shfl_xor(ss, 16); ss += __shfl_xor(ss, 32);
                const float rstd = 0.125f / sqrtf(ss * (1.f / 64.f) + EPS);
                u32x4 o0, o1;
                o0.x = pk2(a[0] * rstd * w0.x, a[1] * rstd * w0.y); o0.y = pk2(a[2] * rstd * w0.z, a[3] * rstd * w0.w); o0.z = pk2(a[4] * rstd * w1.x, a[5] * rstd * w1.y); o0.w = pk2(a[6] * rstd * w1.z, a[7] * rstd * w1.w);
                o1.x = pk2(c[0] * rstd * w2.x, c[1] * rstd * w2.y); o1.y = pk2(c[2] * rstd * w2.z, c[3] * rstd * w2.w); o1.z = pk2(c[4] * rstd * w3.x, c[5] * rstd * w3.y); o1.w = pk2(c[6] * rstd * w3.z, c[7] * rstd * w3.w);
                qf[h2][0] = __builtin_bit_cast(bf16x8, o0); qf[h2][1] = __builtin_bit_cast(bf16x8, o1); }
            int Ld[2]; unsigned hiu[2];
#pragma unroll
            for (int h2 = 0; h2 < 2; ++h2) { const int lo = max(1, (j == 0 ? 128 : 0) - qi[h2]); Ld[h2] = 4 * fq - fr - lo; hiu[h2] = (unsigned)(128 - lo); }
            f32x4 sa[2][10]; float mx[2] = {sink, sink};
#pragma unroll
            for (int kt = 0; kt < 10; ++kt) { sa[0][kt] = (f32x4){0.f, 0.f, 0.f, 0.f}; sa[1][kt] = (f32x4){0.f, 0.f, 0.f, 0.f};
#pragma unroll
                for (int kk = 0; kk < 2; ++kk) { const bf16x8 kf = *(const LAS bf16x8*)(lds + KSB + (kstart + 16 * kt + fr) * KSTR + kk * 64 + fq * 16);
                    sa[0][kt] = mfma16(kf, qf[0][kk], sa[0][kt]); sa[1][kt] = mfma16(kf, qf[1][kk], sa[1][kt]); }
#pragma unroll
                for (int h2 = 0; h2 < 2; ++h2)
#pragma unroll
                    for (int i = 0; i < 4; ++i) { const bool valid = (unsigned)(Ld[h2] + (16 * (kt - h2) + i)) <= hiu[h2];
                        sa[h2][kt][i] = valid ? sa[h2][kt][i] : -INFINITY; mx[h2] = fmaxf(mx[h2], sa[h2][kt][i]); } }
            unsigned pw[2][10][2]; float inv[2];
#pragma unroll
            for (int h2 = 0; h2 < 2; ++h2) { float m2 = mx[h2]; m2 = fmaxf(m2, __shfl_xor(m2, 16)); m2 = fmaxf(m2, __shfl_xor(m2, 32));
                float sum = 0.f;
#pragma unroll
                for (int kt = 0; kt < 10; ++kt) { float p[4];
#pragma unroll
                    for (int i = 0; i < 4; ++i) { p[i] = __expf(sa[h2][kt][i] - m2); sum += p[i]; }
                    pw[h2][kt][0] = pk2(p[0], p[1]); pw[h2][kt][1] = pk2(p[2], p[3]); }
                sum += __shfl_xor(sum, 16); sum += __shfl_xor(sum, 32);
                inv[h2] = 1.f / (sum + __expf(sink - m2)); }
#pragma unroll
            for (int dt = 0; dt < 4; ++dt) { f32x4 oa[2] = {(f32x4){0.f, 0.f, 0.f, 0.f}, (f32x4){0.f, 0.f, 0.f, 0.f}};
#pragma unroll
                for (int kb = 0; kb < 5; ++kb) { const int gv = (2 * dt + (fr >> 3)) & 7, b0 = (kstart >> 3) + 4 * kb + (fq >> 1); const LAS unsigned char* vr = lds + VTB + (16 * dt + fr) * VSTR + (fq & 1) * 8;
                    const s16x4 lo = *(const LAS s16x4*)(vr + ((b0 ^ gv) << 4)), hi = *(const LAS s16x4*)(vr + (((b0 + 2) ^ gv) << 4));
                    const bf16x8 vf = (bf16x8){lo[0], lo[1], lo[2], lo[3], hi[0], hi[1], hi[2], hi[3]};
#pragma unroll
                    for (int h2 = 0; h2 < 2; ++h2) { const u32x4 pu = (u32x4){pw[h2][2 * kb][0], pw[h2][2 * kb][1], pw[h2][2 * kb + 1][0], pw[h2][2 * kb + 1][1]};
                        oa[h2] = mfma16(vf, __builtin_bit_cast(bf16x8, pu), oa[h2]); } }
#pragma unroll
                for (int h2 = 0; h2 < 2; ++h2) { const f32x4 ov = oa[h2] * inv[h2];
                    u32x2 w; w.x = pk2(ov.x, ov.y); w.y = pk2(ov.z, ov.w);
                    *(u32x2*)(O + tok[h2] * D + head * 64 + 16 * dt + 4 * fq) = w; } }
        }
        __syncthreads();
    }
}

__device__ __forceinline__ void conv_fixup(const float* __restrict__ SBUF, bf16* __restrict__ A2, const float* __restrict__ cw, const float* __restrict__ cb, const pg8::StaticOrder& S, int tid_) {
    int tid = tid_; asm volatile("" : "+v"(tid));
    pg8::Unit u; int prev = -1;
    for (int i = 0; S.next(i, u); ++i) {
        if (u.pm == prev) continue; prev = u.pm;
        if ((u.pm & 7) == 0) continue;
        const float* tl = SBUF + (size_t)((u.pm - 1) * 4 + 2) * FF2; const float* hd = SBUF + (size_t)(u.pm * 4) * FF2;
        for (int q = tid; q < FF / 4; q += NTHR) { const int c = 4 * q;
            const f32x4 g0 = *(const f32x4*)(tl + c), g1 = *(const f32x4*)(tl + FF2 + c), g2 = *(const f32x4*)(hd + c), g3 = *(const f32x4*)(hd + FF2 + c);
            const f32x4 v0 = *(const f32x4*)(tl + FF + c), v1 = *(const f32x4*)(tl + FF2 + FF + c), v2 = *(const f32x4*)(hd + FF + c), v3 = *(const f32x4*)(hd + FF2 + FF + c);
            const f32x4 a0 = *(const f32x4*)(cw + c), a1 = *(const f32x4*)(cw + FF2 + c), a2 = *(const f32x4*)(cw + 2 * FF2 + c), ab = *(const f32x4*)(cb + c);
            const f32x4 b0 = *(const f32x4*)(cw + FF + c), b1 = *(const f32x4*)(cw + FF2 + FF + c), b2 = *(const f32x4*)(cw + 2 * FF2 + FF + c), bb = *(const f32x4*)(cb + FF + c);
            const f32x4 G0 = a0 * g0 + a1 * g1 + a2 * g2 + ab, G1 = a0 * g1 + a1 * g2 + a2 * g3 + ab, V0 = b0 * v0 + b1 * v1 + b2 * v2 + bb, V1 = b0 * v1 + b1 * v2 + b2 * v3 + bb;
            float o0[4], o1[4];
#pragma unroll
            for (int e2 = 0; e2 < 4; ++e2) { o0[e2] = G0[e2] / (1.f + __expf(-G0[e2])) * V0[e2]; o1[e2] = G1[e2] / (1.f + __expf(-G1[e2])) * V1[e2]; }
            u32x2 w0, w1; w0.x = pk2(o0[0], o0[1]); w0.y = pk2(o0[2], o0[3]); w1.x = pk2(o1[0], o1[1]); w1.y = pk2(o1[2], o1[3]);
            *(u32x2*)(A2 + (size_t)(u.pm * 256) * FF + c) = w0; *(u32x2*)(A2 + (size_t)(u.pm * 256 + 1) * FF + c) = w1;
        }
    }
    asm volatile("s_waitcnt vmcnt(0)" ::: "memory"); __syncthreads();
}
#define XB_TMO      128
#define XB_XCNT(j)  (256  + 64 * (j))
#define XB_XSUB(j)  (1280 + 64 * (j))
#define XB_XGEN(j)  (2304 + 64 * (j))
#define XB_TOP      3328
#define XB_TOPGEN   3392
#define XCD_BAR_WORDS 3456
#define XB_SPIN_CAP (1u << 18)

__device__ __forceinline__ unsigned xb_ld(unsigned* p)              { return __hip_atomic_load(p, __ATOMIC_RELAXED, __HIP_MEMORY_SCOPE_AGENT); }
__device__ __forceinline__ unsigned xb_add(unsigned* p, unsigned v) { return __hip_atomic_fetch_add(p, v, __ATOMIC_RELAXED, __HIP_MEMORY_SCOPE_AGENT); }
__device__ __forceinline__ unsigned xb_xcc_id() { return (unsigned)__builtin_amdgcn_s_getreg((3 << 11) | 20) & 0xFu; }
#define XB_SPIN(cond, bar) do { unsigned _sp = 0; while (cond) { __builtin_amdgcn_s_sleep(1); \
    if ((++_sp & 255u) == 0u) { if (xb_ld(&(bar)[XB_TMO])) break; if (_sp > XB_SPIN_CAP) { atomicAdd(&(bar)[XB_TMO], 1u); break; } } } } while (0)

struct XcdBarrier {
    unsigned* bar; unsigned x;
    volatile LAS unsigned* st;
};

__device__ __forceinline__ XcdBarrier xcd_barrier_post(unsigned* bar, volatile LAS unsigned* st) {
    XcdBarrier b; b.bar = bar; b.x = xb_xcc_id(); b.st = st;
    if (threadIdx.x == 0) (void)xb_add(&bar[XB_XCNT(b.x)], 1u);
    return b;
}
__device__ __forceinline__ void xcd_barrier_complete(unsigned* bar, unsigned x, unsigned& nloc, unsigned& nx) {
    const unsigned G = gridDim.x * gridDim.y * gridDim.z;
    unsigned sum, cnt, mine, sp = 0u;
    for (;;) {
        sum = 0u; cnt = 0u; mine = 0u;
#pragma unroll
        for (unsigned j = 0; j < 16; ++j) { const unsigned c = xb_ld(&bar[XB_XCNT(j)]); sum += c; cnt += (c > 0u) ? 1u : 0u; mine = (j == x) ? c : mine; }
        if (sum == G) break;
        __builtin_amdgcn_s_sleep(1);
        if ((++sp & 255u) == 0u) { if (xb_ld(&bar[XB_TMO])) break; if (sp > XB_SPIN_CAP) { atomicAdd(&bar[XB_TMO], 1u); break; } }
    }
    nloc = mine > 0u ? mine : 1u; nx = cnt > 0u ? cnt : 1u;
}

__device__ __forceinline__ void xcd_barrier(const XcdBarrier& b) {
    asm volatile("s_waitcnt vmcnt(0)" ::: "memory");
    __syncthreads();
    if (threadIdx.x == 0) {
        unsigned* bar = b.bar;
        __builtin_amdgcn_s_waitcnt(0);
        unsigned nloc = b.st[0], nx = b.st[1];
        if (nloc == 0u) { xcd_barrier_complete(bar, b.x, nloc, nx); b.st[0] = nloc; b.st[1] = nx; }
        const unsigned old = xb_add(&bar[XB_XSUB(b.x)], 1u);
        const unsigned gen = old / nloc;
        if (old + 1u == (gen + 1u) * nloc) {
            __builtin_amdgcn_fence(__ATOMIC_RELEASE, "agent");
            asm volatile("s_waitcnt vmcnt(0)" ::: "memory");
            const unsigned og = xb_add(&bar[XB_TOP], 1u);
            const unsigned tg = og / nx;
            if (og + 1u == (tg + 1u) * nx) xb_add(&bar[XB_TOPGEN], 1u);
            else XB_SPIN(xb_ld(&bar[XB_TOPGEN]) == tg, bar);
            __builtin_amdgcn_fence(__ATOMIC_ACQUIRE, "agent");
            xb_add(&bar[XB_XGEN(b.x)], 1u);
            asm volatile("s_waitcnt vmcnt(0)" ::: "memory");
        } else {
            XB_SPIN(xb_ld(&bar[XB_XGEN(b.x)]) == gen, bar);
            __builtin_amdgcn_fence(__ATOMIC_ACQUIRE, "agent");
            asm volatile("s_waitcnt vmcnt(0)" ::: "memory");
        }
    }
    __syncthreads();
}

__device__ __forceinline__ void group_barrier(unsigned* cnt, unsigned nmemb) {
    asm volatile("s_waitcnt vmcnt(0)" ::: "memory");
    __syncthreads();
    if (threadIdx.x == 0) {
        __builtin_amdgcn_fence(__ATOMIC_RELEASE, "agent");
        asm volatile("s_waitcnt vmcnt(0)" ::: "memory");
        const unsigned old = xb_add(cnt, 1u), target = (old / nmemb + 1u) * nmemb;
        unsigned sp = 0u;
        while (xb_ld(cnt) < target) { __builtin_amdgcn_s_sleep(1); if (++sp > (1u << 22)) break; }
        __builtin_amdgcn_fence(__ATOMIC_ACQUIRE, "agent");
        asm volatile("s_waitcnt vmcnt(0)" ::: "memory");
    }
    __syncthreads();
}

struct Params { const float* in[23]; float* out; unsigned char* ws; int ph_lo, ph_hi, use_cg, pad; };
constexpr int N_PHASES = 18;
#ifndef PROBE_D
#define PROBE_D (-1)
#endif
#ifndef PROBE_R
#define PROBE_R (-1)
#endif
#define PROBING (PROBE_D != -1 || PROBE_R != -1)

__global__ void __launch_bounds__(NTHR, 2) fwd_kernel(Params P) {
    extern __shared__ __attribute__((aligned(16))) unsigned char lds_raw[];
    LAS unsigned char* lds = (LAS unsigned char*)lds_raw;
    cg::grid_group grid = cg::this_grid();
    const int tid = threadIdx.x, lane = tid & 63, wave = __builtin_amdgcn_readfirstlane(tid >> 6);
    const int G = gridDim.x, gw = blockIdx.x * NWAVES + wave, NGW = G * NWAVES, gtid = blockIdx.x * NTHR + tid, gthreads = G * NTHR;
    unsigned char* ws = P.ws;
    const float* x = P.in[0]; const float* cvec = P.in[1];
    float* mod0 = (float*)(ws + WS_MOD); float* mod1 = mod0 + 8 * MODW;
    float* Gg = (float*)(ws + WS_G); float* SS = (float*)(ws + WS_SS);
    bf16* WG = (bf16*)(ws + WS_WG); bf16* WA = (bf16*)(ws + WS_W_A); bf16* WB = (bf16*)(ws + WS_W_B); bf16* WC = (bf16*)(ws + WS_W_C); bf16* WD = (bf16*)(ws + WS_W_D);
    bf16* A2 = (bf16*)(ws + WS_A2); bf16* XN = (bf16*)(ws + WS_XN); float* SBUF = (float*)(ws + WS_SB); bf16* QKVO = (bf16*)(ws + WS_QKVO);
    bf16* Hb = (bf16*)(ws + WS_H); bf16* HS = (bf16*)(ws + WS_HS);
    bf16* WA1 = (bf16*)(ws + WS_W1_A); bf16* WB1 = (bf16*)(ws + WS_W1_B); bf16* WC1 = (bf16*)(ws + WS_W1_C); bf16* WD1 = (bf16*)(ws + WS_W1_D);
    const int rowsel = 2048 * ((int)blockIdx.x & 7) + ((int)blockIdx.x >> 3) * NWAVES + wave;
    unsigned* gcnt = (unsigned*)(ws + WS_GBAR) + 64 * ((int)blockIdx.x & 7);
    float* out = P.out;
    const int lo = P.ph_lo, hi = P.ph_hi;
    volatile LAS unsigned* MISC = (volatile LAS unsigned*)(lds + LDS_BYTES - 128);
    if (tid < 32) MISC[tid] = 0u;
    __syncthreads();
    XcdBarrier bar = xcd_barrier_post((unsigned*)(ws + WS_BAR), MISC + 8);
#define IN(k) (lo <= (k) && (k) < hi)
#define GRIDBAR() do { if (P.use_cg) grid.sync(); else xcd_barrier(bar); } while (0)
#define SEAM_(k) do { if (IN(k) && IN((k) + 1)) { if ((k) == 0 || (k) == 3 || G != 256) GRIDBAR(); else group_barrier(gcnt, 32u); } } while (0)
#if PROBING
    unsigned long long tb_d = 0, te_d = 0, tb_r = 0, te_r = 0;
#define SB(k) do { if ((k) == PROBE_D) tb_d = __builtin_amdgcn_s_memrealtime(); if ((k) == PROBE_R) tb_r = __builtin_amdgcn_s_memrealtime(); } while (0)
#define SEAM(k) do { SEAM_(k); if ((k) == PROBE_D) te_d = __builtin_amdgcn_s_memrealtime(); if ((k) == PROBE_R) te_r = __builtin_amdgcn_s_memrealtime(); } while (0)
#else
#define SB(k) do {} while (0)
#define SEAM(k) SEAM_(k)
#endif

    SB(0); if (IN(0)) {
        if (blockIdx.x < 192) { const int w = blockIdx.x, l = w / 96, r = w % 96;
            mod_task(cvec, l ? P.in[12] : P.in[2], l ? P.in[13] : P.in[3], l ? mod1 : mod0, r >> 1, r & 1, lds, tid, wave, lane); }
        const ConvJob j0{P.in[4], WA, 2048, LD_WIN, N_IN, 32 * (N_IN / 32)}, jz{P.in[4], WA, 2048, LD_WIN, N_IN, 0};
        { const bool lite = (G == 256) && blockIdx.x >= 192;
          convert_weights(j0, jz, jz, jz, lds, lite ? 1536 + ((int)(blockIdx.x - 192) * NWAVES + wave) * 2 : gw, lite ? 2 : 1, (G == 256) ? 2560 : NGW, wave, lane); }
        for (int e = gtid; e < 16 * 2048; e += gthreads) { const int g = e >> 11, k = e & 2047; WG[e] = (bf16)f2bf(P.in[4][(size_t)k * LD_WIN + N_IN + g]); }
        __syncthreads();
    }
    SEAM(0);
    SB(1); if (IN(1)) norm_mod_rows(x, XN, mod0 + 0 * 2048, mod0 + 1 * 2048, rowsel, lane);
    SEAM(1);
    SB(2); if (IN(2)) {
        pg8::Gemm g{XN, WA, M, N_IN, D}; pg8::StaticOrder S; S.init(M, N_IN, G, (int)blockIdx.x);
        pg8::EpiBf16<0> E{QKVO, N_IN, nullptr, 1024, 1024, 0.08838834764831845f};
        pg8::gemm_phase<pg8::EpiBf16<0>, pg8::StaticOrder, true, true>(lds, g, S, E);
        gate_gemm(XN, WG, P.in[5], Gg, wave, lane);
    }
    SEAM(2);
    SB(3); if (IN(3)) mlstm_phase(lds, QKVO, Gg, Hb, SS, P.in[7], P.in[8], P.in[11], P.in[14], P.in[18], P.in[19], P.in[22], WB, WC, WD, WA1, WB1, WC1, WD1, gw, NGW, tid, wave, lane);
    SEAM(3);
    SB(4); if (IN(4)) headnorm_rows(Hb, QKVO, SS, P.in[6], HS, rowsel, lane);
    SEAM(4);
    SB(5); if (IN(5)) {
        pg8::Gemm g{HS, WB, M, D, D}; pg8::StaticOrder S; S.init(M, D, G, (int)blockIdx.x);
        pg8::EpiResGate E{x, out, mod0 + 2 * 2048, MODW};
        pg8::gemm_phase<pg8::EpiResGate, pg8::StaticOrder, true, true>(lds, g, S, E);
    }
    SEAM(5);
    SB(6); if (IN(6)) norm_mod_rows(out, XN, mod0 + 3 * 2048, mod0 + 4 * 2048, rowsel, lane);
    SEAM(6);
    SB(7); if (IN(7)) {
        pg8::Gemm g{XN, WC, M, FF2, D}; pg8::StaticOrder S; S.init(M, FF2, G, (int)blockIdx.x);
        pg8::EpiConvAct E{A2, P.in[9], P.in[10], SBUF, lds + 132096};
        pg8::gemm_phase<pg8::EpiConvAct, pg8::StaticOrder, true, true>(lds, g, S, E);
    }
    SEAM(7);
    SB(9); if (IN(9)) {
        pg8::Gemm g{A2, WD, M, D, FF}; pg8::StaticOrder S; S.init(M, D, G, (int)blockIdx.x);
        conv_fixup(SBUF, A2, P.in[9], P.in[10], S, tid);
        pg8::EpiResGate E{out, out, mod0 + 5 * 2048, MODW};
        pg8::gemm_phase<pg8::EpiResGate, pg8::StaticOrder, true, true>(lds, g, S, E);
    }
    SEAM(9);
    SB(10); if (IN(10)) {
        norm_mod_rows(out, XN, mod1 + 0 * 2048, mod1 + 1 * 2048, rowsel, lane);
    }
    SEAM(10);
    SB(11); if (IN(11)) {
        pg8::Gemm g{XN, WA1, M, N_QKV, D}; pg8::StaticOrder S; S.init(M, N_QKV, G, (int)blockIdx.x);
        pg8::EpiBf16<0> E{QKVO, N_QKV, nullptr, 0, 0, 1.f};
        pg8::gemm_phase<pg8::EpiBf16<0>, pg8::StaticOrder, true, true>(lds, g, S, E);
    }
    SEAM(11);
    SB(12); if (IN(12)) swa_phase(lds, QKVO, P.in[15], P.in[16], P.in[17], Hb, tid, wave, lane);
    SEAM(12);
    SB(13); if (IN(13)) {
        pg8::Gemm g{Hb, WB1, M, D, D}; pg8::StaticOrder S; S.init(M, D, G, (int)blockIdx.x);
        pg8::EpiResGate E{out, out, mod1 + 2 * 2048, MODW};
        pg8::gemm_phase<pg8::EpiResGate, pg8::StaticOrder, true, true>(lds, g, S, E);
    }
    SEAM(13);
    SB(14); if (IN(14)) norm_mod_rows(out, XN, mod1 + 3 * 2048, mod1 + 4 * 2048, rowsel, lane);
    SEAM(14);
    SB(15); if (IN(15)) {
        pg8::Gemm g{XN, WC1, M, FF2, D}; pg8::StaticOrder S; S.init(M, FF2, G, (int)blockIdx.x);
        pg8::EpiConvAct E{A2, P.in[20], P.in[21], SBUF, lds + 132096};
        pg8::gemm_phase<pg8::EpiConvAct, pg8::StaticOrder, true, true>(lds, g, S, E);
    }
    SEAM(15);
    SB(17); if (IN(17)) {
        pg8::Gemm g{A2, WD1, M, D, FF}; pg8::StaticOrder S; S.init(M, D, G, (int)blockIdx.x);
        conv_fixup(SBUF, A2, P.in[20], P.in[21], S, tid);
        pg8::EpiResGate E{out, out, mod1 + 5 * 2048, MODW};
        pg8::gemm_phase<pg8::EpiResGate, pg8::StaticOrder, true, true>(lds, g, S, E);
    }
#if PROBING
    GRIDBAR();
    { const unsigned long long tn = __builtin_amdgcn_s_memrealtime();
      if (17 == PROBE_D) te_d = tn; if (17 == PROBE_R) te_r = tn;
      if (PROBE_D == 200 || PROBE_R == 200) { GRIDBAR(); const unsigned long long t0 = __builtin_amdgcn_s_memrealtime(); GRIDBAR(); const unsigned long long t1 = __builtin_amdgcn_s_memrealtime();
          if (PROBE_D == 200) { tb_d = t0; te_d = t1; } if (PROBE_R == 200) { tb_r = t0; te_r = t1; } }
      if (blockIdx.x == 0) {
          if (PROBE_R != -1) { const int K = (PROBE_R == -2) ? 20000 : (PROBE_R == 200 ? (int)(te_r - tb_r) : (int)((te_r - tb_r) / 100ull)); for (int i = tid; i < K; i += NTHR) out[i] += 0.25f; }
          if (PROBE_D != -1) { const unsigned long long t0 = __builtin_amdgcn_s_memrealtime(), w = (PROBE_D == 200 ? 800ull : 8ull) * (te_d - tb_d); while (__builtin_amdgcn_s_memrealtime() - t0 < w) __builtin_amdgcn_s_sleep(8); } } }
#endif
#undef IN
#undef SEAM
}

#ifndef ONE_LAUNCH
#define ONE_LAUNCH 1
#endif
extern "C" void kernel_launch(void* const* d_in, const int* in_sizes, int n_in, void* d_out, int out_size, void* d_ws, size_t ws_size, hipStream_t stream) {
    static int grid = 0;
    if (grid == 0) {
        if (n_in != 23 || in_sizes[0] != M * D || out_size != M * D || ws_size < WS_END) { fprintf(stderr, "kernel_launch: unexpected shapes (n_in %d, ws %zu); nothing launched\n", n_in, ws_size); grid = -1; return; }
        int dev = 0, cus = 0, per_cu = 0;
        if (hipGetDevice(&dev) != hipSuccess || hipDeviceGetAttribute(&cus, hipDeviceAttributeMultiprocessorCount, dev) != hipSuccess) { grid = -1; return; }
        if (hipFuncSetAttribute((const void*)fwd_kernel, hipFuncAttributeMaxDynamicSharedMemorySize, LDS_BYTES) != hipSuccess) { fprintf(stderr, "kernel_launch: hipFuncSetAttribute failed\n"); grid = -1; return; }
        if (hipOccupancyMaxActiveBlocksPerMultiprocessor(&per_cu, (const void*)fwd_kernel, NTHR, LDS_BYTES) != hipSuccess || per_cu < 1) { fprintf(stderr, "kernel_launch: occupancy query says %d\n", per_cu); per_cu = 1; }
        (void)hipGetLastError();
        grid = cus;
    }
    if (grid < 0) return;
    (void)hipMemsetAsync((char*)d_ws, 0, CTL_ZERO_BYTES, stream);
    Params p{};
    for (int i = 0; i < 23; ++i) p.in[i] = (const float*)d_in[i];
    p.out = (float*)d_out; p.ws = (unsigned char*)d_ws;
#if ONE_LAUNCH
    p.ph_lo = 0; p.ph_hi = N_PHASES;
    void* args[] = {&p};
    hipError_t e = hipLaunchCooperativeKernel((const void*)fwd_kernel, dim3(grid), dim3(NTHR), args, LDS_BYTES, stream);
    if (e != hipSuccess) fprintf(stderr, "cooperative launch failed: %s (grid %d)\n", hipGetErrorString(e), grid);
#else
    for (int ph = 0; ph < N_PHASES; ++ph) { p.ph_lo = ph; p.ph_hi = ph + 1; hipLaunchKernelGGL(fwd_kernel, dim3(grid), dim3(NTHR), LDS_BYTES, stream, p); }
#endif
}
```

```cpp
#include <hip/hip_runtime.h>
#include <hip/hip_cooperative_groups.h>
#include <cstdio>
#include <cstdint>
#include <cmath>
namespace cg = cooperative_groups;
namespace pg8 {
#define PG8_LAS __attribute__((address_space(3)))
typedef unsigned short bf16_t;
typedef short bf16x8 __attribute__((ext_vector_type(8)));
typedef float f32x4 __attribute__((ext_vector_type(4)));
typedef unsigned u32x4 __attribute__((ext_vector_type(4)));
constexpr int BM = 256, BK = 64, HALF = 128, HTB = HALF * BK * 2  , STAGE_BYTES = 8 * HTB, NXCD = 8, WGM = 8;

__host__ __device__ __forceinline__ int lds_byte(int r, int c) { const int st = (r >> 4) * 2 + (c >> 5), rr = r & 15, cc = c & 31, ob = rr * 64 + cc * 2; return st * 1024 + (ob ^ (((ob >> 9) & 1) << 5)); }
__host__ __device__ __forceinline__ void stage_rc(int b, int& R, int& C) { const int st = b / 1024, sb = b % 1024, swz = sb ^ (((sb >> 9) & 1) << 5); R = (st >> 1) * 16 + swz / 64; C = (st & 1) * 32 + (swz % 64) / 2; }
__host__ __device__ __forceinline__ int perm32(int rho) { const int n = rho >> 4, i = rho & 15; return 8 * (i >> 2) + 4 * n + (i & 3); }

struct Unit { int pm, pn; };
struct Gemm { const bf16_t* A; const bf16_t* Bt; int M, N, K; };

struct StaticOrder {
    int nM, nN, nwg, G, c;
    __host__ __device__ void init(int M, int N, int G_, int c_) { nM = M / BM; nN = N / BM; nwg = nM * nN; G = G_; c = c_; }
    __host__ __device__ bool next(int i, Unit& u) const {
        const long L = (long)i * G + c; if (L >= nwg) return false;
        int wgid = (int)L; { const int q = nwg / NXCD, r = nwg % NXCD, xcd = wgid % NXCD, off = wgid / NXCD; wgid = (xcd < r ? xcd * (q + 1) : r * (q + 1) + (xcd - r) * q) + off; }
        const int nig = WGM * nN, gid = wgid / nig, fm = gid * WGM, gsz = (nM - fm) < WGM ? (nM - fm) : WGM;
        u.pm = fm + ((wgid % nig) % gsz); u.pn = (wgid % nig) / gsz; return true;
    }
    __device__ __forceinline__ void a_ready(const Unit&) const {}
    __device__ __forceinline__ void done(const Unit&) const {}
};

__device__ __forceinline__ unsigned cvt_pk_bf16(float lo, float hi) { unsigned r; asm volatile("v_cvt_pk_bf16_f32 %0, %1, %2" : "=v"(r) : "v"(lo), "v"(hi)); return r; }
typedef float f32x2 __attribute__((ext_vector_type(2)));
__device__ __forceinline__ f32x2 gelu_pk(f32x2 v) {
    const f32x2 av = __builtin_elementwise_abs(v), d = av * 0.2316418882f + 1.0f;
    f32x2 t; t.x = __builtin_amdgcn_rcpf(d.x); t.y = __builtin_amdgcn_rcpf(d.y);
    f32x2 q = t * 0.5307027145f + (-0.7265760135f); q = q * t + 0.7107068705f; q = q * t + (-0.142248368f); q = q * t + 0.127414796f; q = q * t;
    const f32x2 s = (v * v) * (-0.72134752044f);
    f32x2 e; e.x = __builtin_amdgcn_exp2f(s.x); e.y = __builtin_amdgcn_exp2f(s.y);
    const f32x2 m = v * (q * e), r = v - m;
    f32x2 o; o.x = v.x < 0.f ? m.x : r.x; o.y = v.y < 0.f ? m.y : r.y; return o;
}

template <int ACT  > struct EpiBf16 {
    static constexpr bool PERM = true, AFTER_DRAIN = false; static_assert(ACT == 0 || ACT == 1, "EpiBf16: ACT is 0 (none) or 1 (gelu_pk)");
    bf16_t* O; int ldc; const float* bias; int split_cols; size_t split_stride; float scale0;
    __device__ __forceinline__ void operator()(const f32x4 (&acc)[2][2][4][2], const Unit& u, int wr, int wc, int fr, int fq) const {
        const int row0 = u.pm * BM + wr * 64 + fr; int colt = u.pn * BM; bf16_t* base = O;
        float sc = 1.f; if (split_cols) { const int t = colt / split_cols; base += (size_t)t * split_stride; colt -= t * split_cols; if (t == 0) sc = scale0; }
        const int col0 = colt + wc * 32 + 8 * fq, bcol0 = u.pn * BM + wc * 32 + 8 * fq;
        f32x4 bv[2][2];
#pragma unroll
        for (int bj = 0; bj < 2; ++bj)
#pragma unroll
            for (int n = 0; n < 2; ++n) bv[bj][n] = bias ? *(const f32x4*)(bias + bcol0 + bj * HALF + 4 * n) : (f32x4){0.f, 0.f, 0.f, 0.f};
#pragma unroll
        for (int ai = 0; ai < 2; ++ai)
#pragma unroll
            for (int m = 0; m < 4; ++m) { bf16_t* rowp = base + (size_t)(row0 + ai * HALF + m * 16) * ldc + col0;
#pragma unroll
                for (int bj = 0; bj < 2; ++bj) { f32x4 v0 = acc[ai][bj][m][0] + bv[bj][0], v1 = acc[ai][bj][m][1] + bv[bj][1];
                    if (ACT == 1) { f32x2 a = gelu_pk((f32x2){v0[0], v0[1]}), b = gelu_pk((f32x2){v0[2], v0[3]}), c = gelu_pk((f32x2){v1[0], v1[1]}), d = gelu_pk((f32x2){v1[2], v1[3]});
                        v0 = (f32x4){a.x, a.y, b.x, b.y}; v1 = (f32x4){c.x, c.y, d.x, d.y}; }
                    v0 = v0 * sc; v1 = v1 * sc; u32x4 w; w.x = cvt_pk_bf16(v0[0], v0[1]); w.y = cvt_pk_bf16(v0[2], v0[3]); w.z = cvt_pk_bf16(v1[0], v1[1]); w.w = cvt_pk_bf16(v1[2], v1[3]);
                    *(u32x4*)(rowp + bj * HALF) = w; } }
    }
};
__device__ __forceinline__ void epi_res_gate_body(const f32x4 (&acc)[2][2][4][2], const float* __restrict__ res, float* __restrict__ out, const float* __restrict__ gate, int row0, int col0) {
#pragma unroll
    for (int bj = 0; bj < 2; ++bj)
#pragma unroll
        for (int n = 0; n < 2; ++n) { const int cc = col0 + bj * HALF + n * 16; const f32x4 gv = *(const f32x4*)(gate + cc);
            f32x4 r[2][4];
#pragma unroll
            for (int ai = 0; ai < 2; ++ai)
#pragma unroll
                for (int m = 0; m < 4; ++m) r[ai][m] = *(const f32x4*)(res + (size_t)(row0 + ai * HALF + m * 16) * 2048 + cc);
#pragma unroll
            for (int ai = 0; ai < 2; ++ai)
#pragma unroll
                for (int m = 0; m < 4; ++m) *(f32x4*)(out + (size_t)(row0 + ai * HALF + m * 16) * 2048 + cc) = r[ai][m] + gv * acc[ai][bj][m][n];
            asm volatile("" ::: "memory"); }
}
struct EpiResGate {
    static constexpr bool PERM = false, AFTER_DRAIN = false;
    const float* res; float* out; const float* gate; int gstride;
    __device__ __forceinline__ void operator()(const f32x4 (&acc)[2][2][4][2], const Unit& u, int wr, int wc, int fr_, int fq_) const {
        int fr = fr_, fq = fq_; asm volatile("" : "+v"(fr), "+v"(fq));
        epi_res_gate_body(acc, res, out, gate + (size_t)((u.pm * BM) >> 11) * gstride, u.pm * BM + wr * 64 + fr, u.pn * BM + wc * 32 + 4 * fq);
    }
};
__device__ __forceinline__ float dpp_prev(float older, float cur, int which) {
    const int o = __builtin_bit_cast(int, older), c = __builtin_bit_cast(int, cur);
    if (which == 1) { const int r = __builtin_amdgcn_update_dpp(0, o, 0x121, 0xf, 0xf, false); return __builtin_bit_cast(float, __builtin_amdgcn_update_dpp(r, c, 0x111, 0xf, 0xf, false)); }
    const int r = __builtin_amdgcn_update_dpp(0, o, 0x122, 0xf, 0xf, false); return __builtin_bit_cast(float, __builtin_amdgcn_update_dpp(r, c, 0x112, 0xf, 0xf, false));
}
struct EpiConvAct {
    static constexpr bool PERM = true, AFTER_DRAIN = false;
    bf16_t* A2; const float* cw; const float* cb; float* SBUF; PG8_LAS unsigned char* halo;
    __device__ __forceinline__ void operator()(const f32x4 (&acc)[2][2][4][2], const Unit& u, int wr, int wc, int fr, int fq) const {
        constexpr int FF = 5632, FF2 = 11264;
        const int cl0 = wc * 32 + 8 * fq;
        PG8_LAS float* hl = (PG8_LAS float*)halo;
        if (fr >= 14) {
#pragma unroll
            for (int ai = 0; ai < 2; ++ai)
#pragma unroll
                for (int bj = 0; bj < 2; ++bj)
#pragma unroll
                    for (int n = 0; n < 2; ++n) *(PG8_LAS f32x4*)(hl + ((((2 * ai + wr) * 2 + (fr - 14)) * 2 + bj) * 128 + cl0 + 4 * n)) = acc[ai][bj][3][n];
            if (wr == 1) {
#pragma unroll
                for (int bj = 0; bj < 2; ++bj)
#pragma unroll
                    for (int n = 0; n < 2; ++n) *(f32x4*)(SBUF + (size_t)(u.pm * 4 + 2 + fr - 14) * FF2 + bj * FF + u.pn * 128 + cl0 + 4 * n) = acc[1][bj][3][n];
            }
        }
        if (wr == 0 && fr < 2) {
#pragma unroll
            for (int bj = 0; bj < 2; ++bj)
#pragma unroll
                for (int n = 0; n < 2; ++n) *(f32x4*)(SBUF + (size_t)(u.pm * 4 + fr) * FF2 + bj * FF + u.pn * 128 + cl0 + 4 * n) = acc[0][bj][0][n];
        }
        asm volatile("s_waitcnt lgkmcnt(0)" ::: "memory"); __builtin_amdgcn_s_barrier(); asm volatile("" ::: "memory");
        u32x4 keep[2][4];
#pragma unroll
        for (int n = 0; n < 2; ++n) {
            const int c = u.pn * 128 + cl0 + 4 * n;
            const f32x4 wg0 = *(const f32x4*)(cw + c), wg1 = *(const f32x4*)(cw + FF2 + c), wg2 = *(const f32x4*)(cw + 2 * FF2 + c), bg = *(const f32x4*)(cb + c);
            const f32x4 wv0 = *(const f32x4*)(cw + FF + c), wv1 = *(const f32x4*)(cw + FF2 + FF + c), wv2 = *(const f32x4*)(cw + 2 * FF2 + FF + c), bv = *(const f32x4*)(cb + FF + c);
#pragma unroll
            for (int ai = 0; ai < 2; ++ai) {
                const int s = 2 * ai + wr;
                f32x4 xhg = (f32x4){0.f, 0.f, 0.f, 0.f}, xhv = (f32x4){0.f, 0.f, 0.f, 0.f};
                if (s > 0) { const int hr = (fr == 15) ? 1 : 0;
                    xhg = *(const PG8_LAS f32x4*)(hl + ((((s - 1) * 2 + hr) * 2 + 0) * 128 + cl0 + 4 * n)); xhv = *(const PG8_LAS f32x4*)(hl + ((((s - 1) * 2 + hr) * 2 + 1) * 128 + cl0 + 4 * n)); }
#pragma unroll
                for (int m = 0; m < 4; ++m) {
                    const f32x4 xg = acc[ai][0][m][n], xv = acc[ai][1][m][n];
                    const f32x4 pg = (m == 0) ? xhg : acc[ai][0][m == 0 ? 0 : m - 1][n], pv = (m == 0) ? xhv : acc[ai][1][m == 0 ? 0 : m - 1][n];
                    float o[4];
#pragma unroll
                    for (int e = 0; e < 4; ++e) {
                        const float g = wg0[e] * dpp_prev(pg[e], xg[e], 2) + wg1[e] * dpp_prev(pg[e], xg[e], 1) + wg2[e] * xg[e] + bg[e];
                        const float v = wv0[e] * dpp_prev(pv[e], xv[e], 2) + wv1[e] * dpp_prev(pv[e], xv[e], 1) + wv2[e] * xv[e] + bv[e];
                        o[e] = g * __builtin_amdgcn_rcpf(1.f + __expf(-g)) * v; }
                    const unsigned w0 = cvt_pk_bf16(o[0], o[1]), w1 = cvt_pk_bf16(o[2], o[3]);
                    if (n == 0) { keep[ai][m].x = w0; keep[ai][m].y = w1; }
                    else { keep[ai][m].z = w0; keep[ai][m].w = w1;
                        *(u32x4*)(A2 + (size_t)(u.pm * BM + ai * HALF + wr * 64 + m * 16 + fr) * FF + u.pn * 128 + cl0) = keep[ai][m]; }
                }
            }
        }
    }
};
template <class Epi, class Sched, bool ALIGN_EPI = false, bool SP2 = false>
__device__ __forceinline__ void gemm_phase(PG8_LAS unsigned char* lds, const Gemm g, const Sched& S, const Epi& E) {
    const int tid = threadIdx.x, wid = __builtin_amdgcn_readfirstlane(tid >> 6), lane = tid & 63, wr = wid >> 2, wc = wid & 3, fr = lane & 15, fq = lane >> 4;
    const int K = g.K, nt = K / BK;
    unsigned voffA[2], voffB[2];
#pragma unroll
    for (int i = 0; i < 2; ++i) { int R, C; stage_rc(tid * 16 + i * 8192, R, C); const int Rb = Epi::PERM ? ((R & ~31) + perm32(R & 31)) : R;
        voffA[i] = (unsigned)(R * K + C) * 2u; voffB[i] = (unsigned)(Rb * K + C) * 2u; }
    const size_t kstep = (size_t)(BK * 2);
    const size_t hstep = (size_t)HALF * K * 2;
    const size_t tstep = 2 * hstep;
    const unsigned ldsw = (unsigned)wid * 1024u;
    const int aoff = lds_byte(wr * 64 + fr, fq * 8), boff = lds_byte(wc * 32 + fr, fq * 8);
#define PG8_SA(b, h) (((b) * 2 + (h)) * HTB)
#define PG8_SB(b, h) ((4 + (b) * 2 + (h)) * HTB)
#define PG8_STAGE(bufoff, gbase, voff) do { _Pragma("unroll") for (int _i = 0; _i < 2; ++_i) \
        __builtin_amdgcn_global_load_lds((const unsigned*)((const char*)(gbase) + (voff)[_i]), (PG8_LAS unsigned*)(lds + (bufoff) + ldsw + _i * 8192), 16, 0, 0); } while (0)
#define PG8_LDA(dst, b, h) do { _Pragma("unroll") for (int m = 0; m < 4; ++m) _Pragma("unroll") for (int k = 0; k < 2; ++k) dst[m][k] = *(const PG8_LAS bf16x8*)(lds + PG8_SA(b, h) + aoff + m * 2048 + k * 1024); } while (0)
#define PG8_LDB(dst, b, h) do { _Pragma("unroll") for (int n = 0; n < 2; ++n) _Pragma("unroll") for (int k = 0; k < 2; ++k) dst[n][k] = *(const PG8_LAS bf16x8*)(lds + PG8_SB(b, h) + boff + n * 2048 + k * 1024); } while (0)
#define PG8_MMA(ai, bj, At, Bt) do { __builtin_amdgcn_s_setprio(1); _Pragma("unroll") for (int m = 0; m < 4; ++m) _Pragma("unroll") for (int n = 0; n < 2; ++n) _Pragma("unroll") for (int k = 0; k < 2; ++k) \
        acc[ai][bj][m][n] = __builtin_amdgcn_mfma_f32_16x16x32_bf16(Bt[n][k], At[m][k], acc[ai][bj][m][n], 0, 0, 0); __builtin_amdgcn_s_setprio(0); } while (0)
#define PG8_WAIT_V(n) asm volatile("s_waitcnt vmcnt(" #n ")" ::: "memory")
#define PG8_WAIT_L(n) asm volatile("s_waitcnt lgkmcnt(" #n ")" ::: "memory")
#define PG8_BAR __builtin_amdgcn_s_barrier()
#define PG8_SCHED __builtin_amdgcn_sched_barrier(0)
    Unit cur, nxt; int ui = 0;
    if (!S.next(0, cur)) return;
    f32x4 acc[2][2][4][2];
#pragma unroll
    for (int a = 0; a < 2; ++a)
#pragma unroll
        for (int b = 0; b < 2; ++b)
#pragma unroll
            for (int m = 0; m < 4; ++m)
#pragma unroll
                for (int n = 0; n < 2; ++n) acc[a][b][m][n] = (f32x4){0.f, 0.f, 0.f, 0.f};
    bf16x8 At[4][2], B0[2][2], B1[2][2];
    const char* cA = (const char*)g.A + (size_t)cur.pm * tstep; const char* cB = (const char*)g.Bt + (size_t)cur.pn * tstep;
    S.a_ready(cur);
    if constexpr (SP2) {
        PG8_STAGE(PG8_SB(0, 0), cB, voffB); PG8_STAGE(PG8_SB(0, 1), cB + hstep, voffB); PG8_STAGE(PG8_SA(0, 0), cA, voffA); PG8_STAGE(PG8_SA(0, 1), cA + hstep, voffA);
        if (wr == 1) PG8_BAR;
        PG8_WAIT_V(2); PG8_BAR;
        PG8_STAGE(PG8_SB(1, 0), cB + kstep, voffB); PG8_STAGE(PG8_SA(1, 0), cA + kstep, voffA); PG8_STAGE(PG8_SB(1, 1), cB + hstep + kstep, voffB);
        PG8_WAIT_V(6); PG8_BAR;
    } else {
        PG8_STAGE(PG8_SB(0, 0), cB, voffB); PG8_STAGE(PG8_SA(0, 0), cA, voffA); PG8_STAGE(PG8_SB(0, 1), cB + hstep, voffB); PG8_STAGE(PG8_SA(0, 1), cA + hstep, voffA);
        if (wr == 1) PG8_BAR;
        PG8_WAIT_V(4); PG8_BAR;
        PG8_STAGE(PG8_SB(1, 0), cB + kstep, voffB); PG8_STAGE(PG8_SA(1, 0), cA + kstep, voffA); PG8_STAGE(PG8_SB(1, 1), cB + hstep + kstep, voffB);
        PG8_WAIT_V(6); PG8_BAR;
    }
    for (;;) {
        const bool has_next = S.next(ui + 1, nxt);
        const char* nA = has_next ? (const char*)g.A + (size_t)nxt.pm * tstep : cA; const char* nB = has_next ? (const char*)g.Bt + (size_t)nxt.pn * tstep : cB;
        for (int t = 0; t < nt; t += 2) {
            const bool last = (t == nt - 2);
            const char* a1 = cA + (size_t)(t + 1) * kstep;
            const char* a2 = last ? nA : cA + (size_t)(t + 2) * kstep; const char* b2 = last ? nB : cB + (size_t)(t + 2) * kstep;
            const char* a3 = a2 + kstep; const char* b3 = b2 + kstep;
            if (last && has_next) S.a_ready(nxt);
            if constexpr (SP2) {
            PG8_LDB(B0, 0, 0); PG8_LDB(B1, 0, 1); PG8_SCHED; PG8_LDA(At, 0, 0); PG8_STAGE(PG8_SA(1, 1), a1 + hstep, voffA);
            PG8_WAIT_V(8); PG8_WAIT_L(0); PG8_BAR; PG8_MMA(0, 0, At, B0); PG8_MMA(0, 1, At, B1); PG8_BAR; PG8_SCHED;
            PG8_LDA(At, 0, 1); PG8_STAGE(PG8_SB(0, 0), b2, voffB); PG8_STAGE(PG8_SB(0, 1), b2 + hstep, voffB); PG8_STAGE(PG8_SA(0, 0), a2, voffA);
            PG8_WAIT_V(8); PG8_WAIT_L(0); PG8_BAR; PG8_MMA(1, 0, At, B0); PG8_MMA(1, 1, At, B1); PG8_BAR; PG8_SCHED;
            PG8_LDB(B0, 1, 0); PG8_LDB(B1, 1, 1); PG8_SCHED; PG8_LDA(At, 1, 0); PG8_STAGE(PG8_SA(0, 1), a2 + hstep, voffA);
            PG8_WAIT_V(8); PG8_WAIT_L(0); PG8_BAR; PG8_MMA(0, 0, At, B0); PG8_MMA(0, 1, At, B1); PG8_BAR; PG8_SCHED;
            PG8_LDA(At, 1, 1); PG8_STAGE(PG8_SB(1, 0), b3, voffB); PG8_STAGE(PG8_SB(1, 1), b3 + hstep, voffB); PG8_STAGE(PG8_SA(1, 0), a3, voffA);
            PG8_WAIT_V(8); PG8_WAIT_L(0); PG8_BAR; PG8_MMA(1, 0, At, B0); PG8_MMA(1, 1, At, B1); PG8_BAR; PG8_SCHED;
            } else {
            PG8_LDB(B0, 0, 0); PG8_SCHED; PG8_LDA(At, 0, 0); PG8_STAGE(PG8_SA(1, 1), a1 + hstep, voffA);
            PG8_WAIT_L(8); PG8_BAR; PG8_WAIT_L(0); PG8_MMA(0, 0, At, B0); PG8_BAR; PG8_SCHED;
            PG8_LDB(B1, 0, 1); PG8_STAGE(PG8_SB(0, 0), b2, voffB);
            PG8_BAR; PG8_WAIT_L(0); PG8_MMA(0, 1, At, B1); PG8_BAR;
            PG8_LDA(At, 0, 1); PG8_STAGE(PG8_SA(0, 0), a2, voffA);
            PG8_BAR; PG8_WAIT_L(0); PG8_MMA(1, 0, At, B0); PG8_BAR; PG8_SCHED;
            PG8_STAGE(PG8_SB(0, 1), b2 + hstep, voffB);
            PG8_WAIT_V(6); PG8_BAR; PG8_MMA(1, 1, At, B1); PG8_BAR;
            PG8_LDB(B0, 1, 0); PG8_SCHED; PG8_LDA(At, 1, 0); PG8_STAGE(PG8_SA(0, 1), a2 + hstep, voffA);
            PG8_WAIT_L(8); PG8_BAR; PG8_WAIT_L(0); PG8_MMA(0, 0, At, B0); PG8_BAR; PG8_SCHED;
            PG8_LDB(B1, 1, 1); PG8_STAGE(PG8_SB(1, 0), b3, voffB);
            PG8_BAR; PG8_WAIT_L(0); PG8_MMA(0, 1, At, B1); PG8_BAR;
            PG8_LDA(At, 1, 1); PG8_STAGE(PG8_SA(1, 0), a3, voffA);
            PG8_BAR; PG8_WAIT_L(0); PG8_MMA(1, 0, At, B0); PG8_BAR; PG8_SCHED;
            PG8_STAGE(PG8_SB(1, 1), b3 + hstep, voffB);
            PG8_WAIT_V(6); PG8_BAR; PG8_MMA(1, 1, At, B1); PG8_BAR;
            }
        }
        if constexpr (ALIGN_EPI) { if (wr == 0) PG8_BAR; }
        if constexpr (!Epi::AFTER_DRAIN) { E(acc, cur, wr, wc, fr, fq); S.done(cur); }
        if (!has_next) break;
#pragma unroll
        for (int a = 0; a < 2; ++a)
#pragma unroll
            for (int b = 0; b < 2; ++b)
#pragma unroll
                for (int m = 0; m < 4; ++m)
#pragma unroll
                    for (int n = 0; n < 2; ++n) acc[a][b][m][n] = (f32x4){0.f, 0.f, 0.f, 0.f};
        cur = nxt; cA = nA; cB = nB; ++ui;
        if constexpr (ALIGN_EPI) { if (wr == 1) PG8_BAR; }
    }
    PG8_WAIT_V(0);
    if constexpr (!ALIGN_EPI) { if (wr == 0) PG8_BAR; }
    PG8_BAR;
    if constexpr (Epi::AFTER_DRAIN) { E.fused(acc, cur, wr, wc, fr, fq, lds, wid, lane); S.done(cur); }
#undef PG8_SA
#undef PG8_SB
#undef PG8_STAGE
#undef PG8_LDA
#undef PG8_LDB
#undef PG8_MMA
#undef PG8_WAIT_V
#undef PG8_WAIT_L
#undef PG8_BAR
#undef PG8_SCHED
}
}

#define LAS __attribute__((address_space(3)))
typedef unsigned short bf16;
typedef float f32x4 __attribute__((ext_vector_type(4)));
typedef short bf16x8 __attribute__((ext_vector_type(8)));
typedef short s16x4 __attribute__((ext_vector_type(4)));
typedef unsigned u32x4 __attribute__((ext_vector_type(4)));
typedef unsigned u32x2 __attribute__((ext_vector_type(2)));

constexpr int NWAVES = 8, NTHR = 512;
constexpr int M = 16384, D = 2048, SEQ = 2048;
constexpr int N_IN = 6144, LD_WIN = 6160, FF = 5632, FF2 = 11264, N_QKV = 2560, MODW = 12288;
constexpr float EPS = 1e-6f;
constexpr int LDS_BYTES = 147456;

constexpr size_t MiB = 1u << 20;
constexpr size_t WS_MOD = 0;
constexpr size_t MOD_BYTES = 2 * 8 * 12288 * 4;
constexpr size_t WS_BAR = 896 * 1024;
constexpr size_t CTL_ZERO_BYTES = 1u << 20;
constexpr size_t WS_G = 1 * MiB;
constexpr size_t WS_SS = 2 * MiB;
constexpr size_t WS_WG = 6 * MiB;
constexpr size_t WS_W_A = 8 * MiB;
constexpr size_t WS_W_B = 32 * MiB;
constexpr size_t WS_W_C = 40 * MiB;
constexpr size_t WS_W_D = 84 * MiB;
constexpr size_t WS_A2 = 112 * MiB;
constexpr size_t WS_QKVO = 112 * MiB;
constexpr size_t WS_H = 304 * MiB;
constexpr size_t WS_HS = 368 * MiB;
constexpr size_t WS_XN = 432 * MiB;
constexpr size_t WS_SB = 496 * MiB;
constexpr size_t WS_W1_A = 512 * MiB, WS_W1_B = 524 * MiB, WS_W1_C = 532 * MiB, WS_W1_D = 576 * MiB;
constexpr size_t WS_GBAR = 920 * 1024;
constexpr size_t WS_END = 600 * MiB;

#define LDS_WAIT() asm volatile("s_waitcnt lgkmcnt(0)" ::: "memory")
__device__ __forceinline__ unsigned f2bf(float f) { unsigned u = __builtin_bit_cast(unsigned, f); return (u + 0x7fffu + ((u >> 16) & 1u)) >> 16; }
__device__ __forceinline__ unsigned pk2(float lo, float hi) { return pg8::cvt_pk_bf16(lo, hi); }
__device__ __forceinline__ float bflo(unsigned w) { return __builtin_bit_cast(float, w << 16); }
__device__ __forceinline__ float bfhi(unsigned w) { return __builtin_bit_cast(float, w & 0xffff0000u); }
__device__ __forceinline__ float wave_sum(float v) {
#pragma unroll
    for (int o = 1; o < 64; o <<= 1) v += __shfl_xor(v, o);
    return v;
}
__device__ __forceinline__ f32x4 mfma16(bf16x8 a, bf16x8 b, f32x4 c) { return __builtin_amdgcn_mfma_f32_16x16x32_bf16(a, b, c, 0, 0, 0); }

__device__ __forceinline__ void transpose_item(const float* W, int K, int ldw, int ncols, bf16* WT, LAS float* scr, int item, int lane, bool upperm) {
    const int nblk = ncols / 32, kb = item / nblk, nb = item % nblk, k0 = 64 * kb, n0 = 32 * nb;
    int r0 = n0; if (upperm) { const int bj = n0 >= FF ? 1 : 0, rem = n0 - bj * FF; r0 = (rem >> 7) * 256 + bj * 128 + (rem & 127); }
#pragma unroll 8
    for (int i = 0; i < 32; ++i) { const int kk = 2 * i + (lane >> 5); scr[kk * 33 + (lane & 31)] = W[(size_t)(k0 + kk) * ldw + n0 + (lane & 31)]; }
    LDS_WAIT(); asm volatile("" ::: "memory");
    const int c = lane & 7;
#pragma unroll
    for (int j = 0; j < 4; ++j) { const int n = (lane >> 3) + 8 * j; const LAS float* s = scr + (8 * c) * 33 + n;
        u32x4 o; o.x = pk2(s[0 * 33], s[1 * 33]); o.y = pk2(s[2 * 33], s[3 * 33]); o.z = pk2(s[4 * 33], s[5 * 33]); o.w = pk2(s[6 * 33], s[7 * 33]);
        *(u32x4*)(WT + (size_t)(r0 + n) * K + k0 + 8 * c) = o; }
    LDS_WAIT(); asm volatile("" ::: "memory");
}
struct ConvJob { const float* W; bf16* WT; int K, ldw, ncols, items; };
__device__ __forceinline__ void convert_weights(const ConvJob& j0, const ConvJob& j1, const ConvJob& j2, const ConvJob& j3, LAS unsigned char* lds, int slot0, int nsl, int T, int wave, int lane) {
    LAS float* scr = (LAS float*)(lds + wave * 16384);
    const int total = j0.items + j1.items + j2.items + j3.items;
    for (int sl = 0; sl < nsl; ++sl)
    for (int it = slot0 + sl; it < total; it += T) {
        int r = it;
        if (r < j0.items) { transpose_item(j0.W, j0.K, j0.ldw, j0.ncols, j0.WT, scr, r, lane, false); continue; } r -= j0.items;
        if (r < j1.items) { transpose_item(j1.W, j1.K, j1.ldw, j1.ncols, j1.WT, scr, r, lane, false); continue; } r -= j1.items;
        if (r < j2.items) { transpose_item(j2.W, j2.K, j2.ldw, j2.ncols, j2.WT, scr, r, lane, true); continue; } r -= j2.items;
        transpose_item(j3.W, j3.K, j3.ldw, j3.ncols, j3.WT, scr, r, lane, false);
    }
}
__device__ __forceinline__ void mod_task(const float* c, const float* wmod, const float* bmod, float* modl, int cg, int kh, LAS unsigned char* lds, int tid, int wave, int lane) {
    LAS float* sl = (LAS float*)lds;
    LAS float* red = (LAS float*)(lds + 32768);
    for (int e = tid; e < 8192; e += NTHR) { const int kk = e >> 3, b = e & 7; const float cv = c[b * 2048 + kh * 1024 + kk]; sl[e] = cv / (1.f + __expf(-cv)); }
    __syncthreads();
    const float* wp = wmod + (size_t)(kh * 1024 + wave * 128) * MODW + cg * 256 + lane * 4;
    f32x4 acc[8];
#pragma unroll
    for (int b = 0; b < 8; ++b) acc[b] = (f32x4){0.f, 0.f, 0.f, 0.f};
#pragma unroll 4
    for (int k = 0; k < 128; ++k) {
        const f32x4 wv = *(const f32x4*)(wp + (size_t)k * MODW);
        const LAS f32x4* sp = (const LAS f32x4*)(sl + (wave * 128 + k) * 8);
        const f32x4 s0 = sp[0], s1 = sp[1];
        acc[0] += s0.x * wv; acc[1] += s0.y * wv; acc[2] += s0.z * wv; acc[3] += s0.w * wv;
        acc[4] += s1.x * wv; acc[5] += s1.y * wv; acc[6] += s1.z * wv; acc[7] += s1.w * wv;
    }
#pragma unroll
    for (int b = 0; b < 8; ++b) *(LAS f32x4*)(red + (wave * 8 + b) * 256 + lane * 4) = acc[b];
    __syncthreads();
    for (int o = tid; o < 2048; o += NTHR) { const int b = o >> 8, col = o & 255; float s = 0.f;
#pragma unroll
        for (int w = 0; w < 8; ++w) s += red[(w * 8 + b) * 256 + col];
        if (kh == 0) s += bmod[cg * 256 + col];
        atomicAdd(modl + (size_t)b * MODW + cg * 256 + col, s); }
    __syncthreads();
}

__device__ __forceinline__ void norm_mod_rows(const float* X, bf16* XN, const float* shift, const float* scale, int r0, int lane) {
    const int b = r0 >> 11; const float* sh = shift + (size_t)b * MODW; const float* sc = scale + (size_t)b * MODW;
    f32x4 a0[4], a1[4], h0[4], h1[4];
#pragma unroll
    for (int j = 0; j < 4; ++j) { const int col = 8 * lane + 512 * j; a0[j] = *(const f32x4*)(sc + col) + 1.f; a1[j] = *(const f32x4*)(sc + col + 4) + 1.f; h0[j] = *(const f32x4*)(sh + col); h1[j] = *(const f32x4*)(sh + col + 4); }
    f32x4 v[4][2], nx[4][2];
#pragma unroll
    for (int j = 0; j < 4; ++j) { const f32x4* p = (const f32x4*)(X + (size_t)r0 * D + 8 * lane + 512 * j); v[j][0] = p[0]; v[j][1] = p[1]; }
    for (int r = r0; r < r0 + 2048; r += 256) {
        const int rn = (r + 256 < r0 + 2048) ? r + 256 : r;
#pragma unroll
        for (int j = 0; j < 4; ++j) { const f32x4* p = (const f32x4*)(X + (size_t)rn * D + 8 * lane + 512 * j); nx[j][0] = p[0]; nx[j][1] = p[1]; }
        float s = 0.f;
#pragma unroll
        for (int j = 0; j < 4; ++j) {
            s += (v[j][0].x * v[j][0].x + v[j][0].y * v[j][0].y) + (v[j][0].z * v[j][0].z + v[j][0].w * v[j][0].w);
            s += (v[j][1].x * v[j][1].x + v[j][1].y * v[j][1].y) + (v[j][1].z * v[j][1].z + v[j][1].w * v[j][1].w); }
        s = wave_sum(s); const float rstd = 1.f / sqrtf(s * (1.f / 2048.f) + EPS);
#pragma unroll
        for (int j = 0; j < 4; ++j) { const int col = 8 * lane + 512 * j;
            const f32x4 o0 = v[j][0] * rstd * a0[j] + h0[j], o1 = v[j][1] * rstd * a1[j] + h1[j];
            u32x4 w; w.x = pk2(o0.x, o0.y); w.y = pk2(o0.z, o0.w); w.z = pk2(o1.x, o1.y); w.w = pk2(o1.z, o1.w);
            *(u32x4*)(XN + (size_t)r * D + col) = w; }
#pragma unroll
        for (int j = 0; j < 4; ++j) { v[j][0] = nx[j][0]; v[j][1] = nx[j][1]; }
    }
}
__device__ __forceinline__ void headnorm_rows(const bf16* H, const bf16* QKVO, const float* SS, const float* hnorm, bf16* HS, int r0, int lane) {
    f32x4 n0[4], n1[4];
#pragma unroll
    for (int j = 0; j < 4; ++j) { const int col = 8 * lane + 512 * j; n0[j] = *(const f32x4*)(hnorm + col); n1[j] = *(const f32x4*)(hnorm + col + 4); }
    u32x4 hv[4], ov[4], nh[4], no[4]; f32x4 s0[4], s1[4], t0[4], t1[4];
#pragma unroll
    for (int j = 0; j < 4; ++j) { const int col = 8 * lane + 512 * j, head = col >> 8;
        hv[j] = *(const u32x4*)(H + (size_t)r0 * D + col); ov[j] = *(const u32x4*)(QKVO + (size_t)r0 * N_IN + 4096 + col);
        s0[j] = *(const f32x4*)(SS + (size_t)r0 * 64 + head * 8); s1[j] = *(const f32x4*)(SS + (size_t)r0 * 64 + head * 8 + 4); }
    for (int r = r0; r < r0 + 2048; r += 256) {
        const int rn = (r + 256 < r0 + 2048) ? r + 256 : r;
#pragma unroll
        for (int j = 0; j < 4; ++j) { const int col = 8 * lane + 512 * j, head = col >> 8;
            nh[j] = *(const u32x4*)(H + (size_t)rn * D + col); no[j] = *(const u32x4*)(QKVO + (size_t)rn * N_IN + 4096 + col);
            t0[j] = *(const f32x4*)(SS + (size_t)rn * 64 + head * 8); t1[j] = *(const f32x4*)(SS + (size_t)rn * 64 + head * 8 + 4); }
#pragma unroll
        for (int j = 0; j < 4; ++j) { const int col = 8 * lane + 512 * j;
            const float ssum = ((s0[j].x + s0[j].y) + (s0[j].z + s0[j].w)) + ((s1[j].x + s1[j].y) + (s1[j].z + s1[j].w));
            const float rstd = 1.f / sqrtf(ssum * (1.f / 256.f) + EPS);
            float hh[8] = {bflo(hv[j].x), bfhi(hv[j].x), bflo(hv[j].y), bfhi(hv[j].y), bflo(hv[j].z), bfhi(hv[j].z), bflo(hv[j].w), bfhi(hv[j].w)};
            float oo[8] = {bflo(ov[j].x), bfhi(ov[j].x), bflo(ov[j].y), bfhi(ov[j].y), bflo(ov[j].z), bfhi(ov[j].z), bflo(ov[j].w), bfhi(ov[j].w)};
            float nn[8] = {n0[j].x, n0[j].y, n0[j].z, n0[j].w, n1[j].x, n1[j].y, n1[j].z, n1[j].w};
            float rr[8];
#pragma unroll
            for (int e2 = 0; e2 < 8; ++e2) rr[e2] = hh[e2] * rstd * nn[e2] / (1.f + __expf(-oo[e2]));
            u32x4 w; w.x = pk2(rr[0], rr[1]); w.y = pk2(rr[2], rr[3]); w.z = pk2(rr[4], rr[5]); w.w = pk2(rr[6], rr[7]);
            *(u32x4*)(HS + (size_t)r * D + col) = w; }
#pragma unroll
        for (int j = 0; j < 4; ++j) { hv[j] = nh[j]; ov[j] = no[j]; s0[j] = t0[j]; s1[j] = t1[j]; }
    }
}
__device__ __forceinline__ void conv_pass(const bf16* U, bf16* A2, const float* cw, const float* cb, int gtid, int gthreads) {
    for (int task = gtid; task < 704 * 512; task += gthreads) {
        const int cgp = task % 704, rr = task / 704, c0 = cgp * 8, r0 = rr * 32;
        float wg[3][8], wv[3][8], bg[8], bv[8];
#pragma unroll
        for (int j = 0; j < 3; ++j)
#pragma unroll
            for (int e = 0; e < 8; ++e) { wg[j][e] = cw[j * FF2 + c0 + e]; wv[j][e] = cw[j * FF2 + FF + c0 + e]; }
#pragma unroll
        for (int e = 0; e < 8; ++e) { bg[e] = cb[c0 + e]; bv[e] = cb[FF + c0 + e]; }
        float g2[8], g1[8], v2[8], v1[8];
        if ((r0 & 2047) == 0) {
#pragma unroll
            for (int e = 0; e < 8; ++e) { g2[e] = 0.f; g1[e] = 0.f; v2[e] = 0.f; v1[e] = 0.f; }
        } else {
            const u32x4 a = *(const u32x4*)(U + (size_t)(r0 - 2) * FF2 + c0), b = *(const u32x4*)(U + (size_t)(r0 - 1) * FF2 + c0);
            const u32x4 c = *(const u32x4*)(U + (size_t)(r0 - 2) * FF2 + FF + c0), d = *(const u32x4*)(U + (size_t)(r0 - 1) * FF2 + FF + c0);
            g2[0] = bflo(a.x); g2[1] = bfhi(a.x); g2[2] = bflo(a.y); g2[3] = bfhi(a.y); g2[4] = bflo(a.z); g2[5] = bfhi(a.z); g2[6] = bflo(a.w); g2[7] = bfhi(a.w);
            g1[0] = bflo(b.x); g1[1] = bfhi(b.x); g1[2] = bflo(b.y); g1[3] = bfhi(b.y); g1[4] = bflo(b.z); g1[5] = bfhi(b.z); g1[6] = bflo(b.w); g1[7] = bfhi(b.w);
            v2[0] = bflo(c.x); v2[1] = bfhi(c.x); v2[2] = bflo(c.y); v2[3] = bfhi(c.y); v2[4] = bflo(c.z); v2[5] = bfhi(c.z); v2[6] = bflo(c.w); v2[7] = bfhi(c.w);
            v1[0] = bflo(d.x); v1[1] = bfhi(d.x); v1[2] = bflo(d.y); v1[3] = bfhi(d.y); v1[4] = bflo(d.z); v1[5] = bfhi(d.z); v1[6] = bflo(d.w); v1[7] = bfhi(d.w);
        }
#pragma unroll 2
        for (int i = 0; i < 32; ++i) {
            const size_t r = (size_t)(r0 + i);
            const u32x4 a = *(const u32x4*)(U + r * FF2 + c0), c = *(const u32x4*)(U + r * FF2 + FF + c0);
            float g0[8] = {bflo(a.x), bfhi(a.x), bflo(a.y), bfhi(a.y), bflo(a.z), bfhi(a.z), bflo(a.w), bfhi(a.w)};
            float v0[8] = {bflo(c.x), bfhi(c.x), bflo(c.y), bfhi(c.y), bflo(c.z), bfhi(c.z), bflo(c.w), bfhi(c.w)};
            float o[8];
#pragma unroll
            for (int e = 0; e < 8; ++e) {
                const float g = wg[0][e] * g2[e] + wg[1][e] * g1[e] + wg[2][e] * g0[e] + bg[e];
                const float v = wv[0][e] * v2[e] + wv[1][e] * v1[e] + wv[2][e] * v0[e] + bv[e];
                o[e] = g / (1.f + __expf(-g)) * v;
                g2[e] = g1[e]; g1[e] = g0[e]; v2[e] = v1[e]; v1[e] = v0[e];
            }
            u32x4 w; w.x = pk2(o[0], o[1]); w.y = pk2(o[2], o[3]); w.z = pk2(o[4], o[5]); w.w = pk2(o[6], o[7]);
            *(u32x4*)(A2 + r * FF + c0) = w;
        }
    }
}

__device__ __forceinline__ void gate_gemm(const bf16* XN, const bf16* WG, const float* gbias, float* G, int wave, int lane) {
    if (wave >= 4) return;
    const int fr = lane & 15, fq = lane >> 4;
    { const int task = ((int)blockIdx.x & 7) * 128 + ((int)blockIdx.x >> 3) * 4 + wave;
        const int r0 = task * 16;
        const bf16* ap = WG + (size_t)fr * D + fq * 8; const bf16* bp = XN + (size_t)(r0 + fr) * D + fq * 8;
        f32x4 acc = (f32x4){0.f, 0.f, 0.f, 0.f};
#pragma unroll 8
        for (int kk = 0; kk < 64; ++kk) { const bf16x8 a = *(const bf16x8*)(ap + kk * 32), b = *(const bf16x8*)(bp + kk * 32); acc = mfma16(a, b, acc); }
        const f32x4 bi = *(const f32x4*)(gbias + 4 * fq);
        f32x4 o;
#pragma unroll
        for (int i = 0; i < 4; ++i) { float g = 15.f * tanhf((acc[i] + bi[i]) * (1.f / 15.f));
            if (fq >= 2) g = fminf(g, 0.f) - log1pf(__expf(-fabsf(g)));
            o[i] = g; }
        *(f32x4*)(G + (size_t)(r0 + fr) * 16 + 4 * fq) = o;
    }
}

struct CvItem { const float* src; bf16* dst; int K; int valid; };
constexpr int CV_ITEMS_TOTAL = 2048 + 11264 + 5632 + 2560 + 2048 + 11264 + 5632;
constexpr int CV_ROWB = 72, CV_TILE = 64 * CV_ROWB;
__device__ __forceinline__ void cv_decode(const float* W0, const float* W1, const float* W2, const float* W3, const float* W4, const float* W5, const float* W6, bf16* T0, bf16* T1, bf16* T2, bf16* T3, bf16* T4, bf16* T5, bf16* T6, int it, int lane, CvItem& I, int& ldw) {
    int j, r = it;
    if (r < 2048) j = 0; else if ((r -= 2048) < 11264) j = 1; else if ((r -= 11264) < 5632) j = 2; else if ((r -= 5632) < 2560) j = 3; else if ((r -= 2560) < 2048) j = 4; else if ((r -= 2048) < 11264) j = 5; else { r -= 11264; j = 6; }
    const int ncols = (j == 1 || j == 5) ? FF2 : (j == 3 ? N_QKV : 2048), K = (j == 2 || j == 6) ? FF : 2048;
    const int nblk = ncols / 32, kb = r / nblk, nb = r % nblk, k0 = 64 * kb, n0 = 32 * nb;
    int r0 = n0; if (j == 1 || j == 5) { const int bj = n0 >= FF ? 1 : 0, rem = n0 - bj * FF; r0 = (rem >> 7) * 256 + bj * 128 + (rem & 127); }
    const float* W = j == 0 ? W0 : j == 1 ? W1 : j == 2 ? W2 : j == 3 ? W3 : j == 4 ? W4 : j == 5 ? W5 : W6;
    bf16* WT = j == 0 ? T0 : j == 1 ? T1 : j == 2 ? T2 : j == 3 ? T3 : j == 4 ? T4 : j == 5 ? T5 : T6;
    ldw = ncols; I.K = K; I.valid = 1;
    I.src = W + (size_t)(k0 + (lane >> 3)) * ncols + n0 + 4 * (lane & 7);
    I.dst = WT + (size_t)r0 * K + k0;
}
__device__ __forceinline__ void mlstm_phase(LAS unsigned char* lds, const bf16* QKVO, const float* G, bf16* H, float* SS, const float* W0, const float* W1, const float* W2, const float* W3, const float* W4, const float* W5, const float* W6, bf16* T0, bf16* T1, bf16* T2, bf16* T3, bf16* T4, bf16* T5, bf16* T6, int gw, int NGW, int tid, int wave, int lane) {
    constexpr int CVS = 109312;
    constexpr int QS = 0, KS = 17408, KT = 34816, VT = 53248, CT = 62464, NS = 79872, GB = 80384, GA = GB + 8192, GC = GA + 8192, RS = 272, TS = 144;
    const int fr = lane & 15, fq = lane >> 4, tt = wave >> 1, vh = wave & 1;
    {
        const int b = (int)blockIdx.x & 7, h = (int)blockIdx.x >> 5, vs = ((int)blockIdx.x >> 3) & 3;
        const size_t rowb = (size_t)b * SEQ;
        for (int e = tid; e < 17408 / 4; e += NTHR) ((LAS unsigned*)(lds + CT))[e] = 0u;
        if (tid < 128) ((LAS float*)(lds + NS))[tid] = 0.f;
#pragma unroll
        for (int cc = 0; cc < 4; ++cc) { const int c = wave + 8 * cc; const size_t gi = (rowb + 64 * c + lane) * 16;
            const float ig = G[gi + h]; float bsum = G[gi + 8 + h];
#pragma unroll
            for (int off = 1; off < 64; off <<= 1) { const float t = __shfl_up(bsum, off); if (lane >= off) bsum += t; }
            const float a = ig - bsum; float cm = a;
#pragma unroll
            for (int off = 1; off < 64; off <<= 1) { const float t = __shfl_up(cm, off); if (lane >= off) cm = fmaxf(cm, t); }
            ((LAS float*)(lds + GB))[64 * c + lane] = bsum; ((LAS float*)(lds + GA))[64 * c + lane] = a; ((LAS float*)(lds + GC))[64 * c + lane] = cm; }
        f32x4 Cacc[4];
#pragma unroll
        for (int vt = 0; vt < 4; ++vt) Cacc[vt] = (f32x4){0.f, 0.f, 0.f, 0.f};
        float m_run = 0.f;
        u32x4 rq[2], rk[2], rv;
        const int vrow = tid >> 3, vc = tid & 7;
#define ML_LOAD(c) do { \
        _Pragma("unroll") for (int i_ = 0; i_ < 2; ++i_) { const int p_ = tid + 512 * i_, prow_ = p_ >> 4, pc_ = p_ & 15; \
            const bf16* src_ = QKVO + (rowb + 64 * (c) + prow_) * N_IN + h * 128 + pc_ * 8; rq[i_] = *(const u32x4*)src_; rk[i_] = *(const u32x4*)(src_ + 1024); } \
        rv = *(const u32x4*)(QKVO + (rowb + 64 * (c) + vrow) * N_IN + 2048 + h * 256 + vs * 64 + vc * 8); } while (0)
        ML_LOAD(0);
        __syncthreads();
        for (int c = 0; c < 32; ++c) {
            const LAS float* gb = (const LAS float*)(lds + GB) + 64 * c; const LAS float* ga = (const LAS float*)(lds + GA) + 64 * c; const LAS float* gc = (const LAS float*)(lds + GC) + 64 * c;
            const float M63 = fmaxf(m_run, gc[63]), total = gb[63];
            const float decay = __expf(m_run - M63);
            { const float wl = __expf(ga[lane] - M63);
#pragma unroll
              for (int i = 0; i < 2; ++i) { const int p = tid + 512 * i, prow = p >> 4, pc = p & 15;
                const float w = __shfl(wl, prow);
                *(LAS u32x4*)(lds + QS + prow * RS + pc * 16) = rq[i]; *(LAS u32x4*)(lds + KS + prow * RS + pc * 16) = rk[i];
                const unsigned kw[4] = {rk[i].x, rk[i].y, rk[i].z, rk[i].w};
                const int ko = ((((prow >> 3) ^ pc) & 7) << 4) + (prow & 7) * 2;
#pragma unroll
                for (int e = 0; e < 4; ++e) { const unsigned pk = pk2(bflo(kw[e]) * w, bfhi(kw[e]) * w);
                    *(LAS unsigned short*)(lds + KT + (pc * 8 + 2 * e) * TS + ko) = (unsigned short)(pk & 0xffffu);
                    *(LAS unsigned short*)(lds + KT + (pc * 8 + 2 * e + 1) * TS + ko) = (unsigned short)(pk >> 16); } } }
            { const unsigned vw[4] = {rv.x, rv.y, rv.z, rv.w};
              const int vo = ((((vrow >> 3) ^ vc) & 7) << 4) + (vrow & 7) * 2;
#pragma unroll
                for (int e = 0; e < 4; ++e) {
                    *(LAS unsigned short*)(lds + VT + (vc * 8 + 2 * e) * TS + vo) = (unsigned short)(vw[e] & 0xffffu);
                    *(LAS unsigned short*)(lds + VT + (vc * 8 + 2 * e + 1) * TS + vo) = (unsigned short)(vw[e] >> 16); } }
            __syncthreads();
            if (c + 1 < 32) ML_LOAD(c + 1);
            CvItem ci; ci.valid = 0; ci.K = 0; ci.src = nullptr; ci.dst = nullptr; int cldw = 0; f32x4 cv[8];
            { const int it = gw + c * NGW; if (it < CV_ITEMS_TOTAL) cv_decode(W0, W1, W2, W3, W4, W5, W6, T0, T1, T2, T3, T4, T5, T6, it, lane, ci, cldw); }
            if (ci.valid) {
#pragma unroll
                for (int i = 0; i < 8; ++i) cv[i] = *(const f32x4*)(ci.src + (size_t)(8 * i) * cldw); }
            const int trow = 16 * tt + fr;
            const float Mt_r = fmaxf(m_run, gc[trow]), wi_r = __expf(m_run - Mt_r), emt_r = __expf(-(gb[trow] + Mt_r));
            bf16x8 qf[4];
#pragma unroll
            for (int kk = 0; kk < 4; ++kk) qf[kk] = *(const LAS bf16x8*)(lds + QS + trow * RS + kk * 64 + fq * 16);
            float rs = 0.f; unsigned pw[4][2];
#pragma unroll
            for (int st = 0; st < 4; ++st) { f32x4 sa = (f32x4){0.f, 0.f, 0.f, 0.f};
#pragma unroll
                for (int kk = 0; kk < 4; ++kk) { const bf16x8 kf = *(const LAS bf16x8*)(lds + KS + (16 * st + fr) * RS + kk * 64 + fq * 16); sa = mfma16(kf, qf[kk], sa); }
                const f32x4 as4 = *(const LAS f32x4*)(ga + 16 * st + 4 * fq);
                float pv[4];
#pragma unroll
                for (int i = 0; i < 4; ++i) { const int s = 16 * st + 4 * fq + i;
                    const float dw = (s <= trow) ? __expf(as4[i] - Mt_r) : 0.f; pv[i] = sa[i] * dw; rs += pv[i]; }
                pw[st][0] = pk2(pv[0], pv[1]); pw[st][1] = pk2(pv[2], pv[3]); }
            rs += __shfl_xor(rs, 16); rs += __shfl_xor(rs, 32);
            float qn = 0.f;
#pragma unroll
            for (int kk = 0; kk < 4; ++kk) { const LAS f32x4* np = (const LAS f32x4*)(lds + NS + (32 * kk + 8 * fq) * 4); const f32x4 n0 = np[0], n1 = np[1];
                const u32x4 qw = __builtin_bit_cast(u32x4, qf[kk]);
                qn += bflo(qw.x) * n0.x + bfhi(qw.x) * n0.y + bflo(qw.y) * n0.z + bfhi(qw.y) * n0.w + bflo(qw.z) * n1.x + bfhi(qw.z) * n1.y + bflo(qw.w) * n1.z + bfhi(qw.w) * n1.w; }
            qn += __shfl_xor(qn, 16); qn += __shfl_xor(qn, 32);
            const float den = wi_r * qn + rs, inv = 1.f / fmaxf(fabsf(den), emt_r);
            float ssq = 0.f;
#pragma unroll
            for (int j = 0; j < 2; ++j) { const int vt = 2 * vh + j; f32x4 o1 = (f32x4){0.f, 0.f, 0.f, 0.f}, o2 = (f32x4){0.f, 0.f, 0.f, 0.f};
#pragma unroll
                for (int kb = 0; kb < 2; ++kb) { const int gv = (2 * vt + (fr >> 3)) & 7; const LAS unsigned char* vr = lds + VT + (16 * vt + fr) * TS + (fq & 1) * 8;
                    const s16x4 lo = *(const LAS s16x4*)(vr + (((4 * kb + (fq >> 1)) ^ gv) << 4)), hi = *(const LAS s16x4*)(vr + (((4 * kb + 2 + (fq >> 1)) ^ gv) << 4));
                    const bf16x8 vf = (bf16x8){lo[0], lo[1], lo[2], lo[3], hi[0], hi[1], hi[2], hi[3]};
                    const u32x4 pu = (u32x4){pw[2 * kb][0], pw[2 * kb][1], pw[2 * kb + 1][0], pw[2 * kb + 1][1]};
                    o1 = mfma16(vf, __builtin_bit_cast(bf16x8, pu), o1); }
#pragma unroll
                for (int kk = 0; kk < 4; ++kk) { const bf16x8 cf = *(const LAS bf16x8*)(lds + CT + (16 * vt + fr) * RS + kk * 64 + fq * 16); o2 = mfma16(cf, qf[kk], o2); }
                const f32x4 hv = (o2 * wi_r + o1) * inv;
                ssq += (hv.x * hv.x + hv.y * hv.y) + (hv.z * hv.z + hv.w * hv.w);
                u32x2 w; w.x = pk2(hv.x, hv.y); w.y = pk2(hv.z, hv.w);
                *(u32x2*)(H + (rowb + 64 * c + trow) * D + h * 256 + vs * 64 + 16 * vt + 4 * fq) = w; }
            ssq += __shfl_xor(ssq, 16); ssq += __shfl_xor(ssq, 32);
            if (fq == 0) SS[(rowb + 64 * c + trow) * 64 + h * 8 + vs * 2 + vh] = ssq;
#pragma unroll
            for (int vt = 0; vt < 4; ++vt) Cacc[vt] = Cacc[vt] * decay;
#pragma unroll
            for (int kb = 0; kb < 2; ++kb) { const bf16x8 ktf = *(const LAS bf16x8*)(lds + KT + (16 * wave + fr) * TS + (((4 * kb + fq) ^ ((2 * wave + (fr >> 3)) & 7)) << 4));
#pragma unroll
                for (int vt = 0; vt < 4; ++vt) { const bf16x8 vtf = *(const LAS bf16x8*)(lds + VT + (16 * vt + fr) * TS + (((4 * kb + fq) ^ ((2 * vt + (fr >> 3)) & 7)) << 4)); Cacc[vt] = mfma16(ktf, vtf, Cacc[vt]); } }
            float ksum = 0.f;
            if (tid < 128) {
#pragma unroll
                for (int e8 = 0; e8 < 8; ++e8) { const u32x4 w = *(const LAS u32x4*)(lds + KT + tid * TS + e8 * 16);
                    ksum += ((bflo(w.x) + bfhi(w.x)) + (bflo(w.y) + bfhi(w.y))) + ((bflo(w.z) + bfhi(w.z)) + (bflo(w.w) + bfhi(w.w))); } }
            __syncthreads();
#pragma unroll
            for (int vt = 0; vt < 4; ++vt) { u32x2 w; w.x = pk2(Cacc[vt].x, Cacc[vt].y); w.y = pk2(Cacc[vt].z, Cacc[vt].w);
                *(LAS u32x2*)(lds + CT + (16 * vt + fr) * RS + (16 * wave + 4 * fq) * 2) = w; }
            if (tid < 128) { LAS float* ns = (LAS float*)(lds + NS); ns[tid] = decay * ns[tid] + ksum; }
            if (ci.valid) { LAS unsigned char* sc = lds + CVS + wave * CV_TILE;
#pragma unroll
                for (int i = 0; i < 8; ++i) { u32x2 w; w.x = pk2(cv[i].x, cv[i].y); w.y = pk2(cv[i].z, cv[i].w);
                    *(LAS u32x2*)(sc + (8 * i + (lane >> 3)) * CV_ROWB + (lane & 7) * 8) = w; }
                LDS_WAIT(); asm volatile("" ::: "memory");
                const int c8 = lane & 7;
#pragma unroll
                for (int j = 0; j < 4; ++j) { const int n = (lane >> 3) + 8 * j; const LAS unsigned char* s = sc + (8 * c8) * CV_ROWB + n * 2;
                    u32x4 o;
                    o.x = (unsigned)*(const LAS unsigned short*)(s + 0 * CV_ROWB) | ((unsigned)*(const LAS unsigned short*)(s + 1 * CV_ROWB) << 16);
                    o.y = (unsigned)*(const LAS unsigned short*)(s + 2 * CV_ROWB) | ((unsigned)*(const LAS unsigned short*)(s + 3 * CV_ROWB) << 16);
                    o.z = (unsigned)*(const LAS unsigned short*)(s + 4 * CV_ROWB) | ((unsigned)*(const LAS unsigned short*)(s + 5 * CV_ROWB) << 16);
                    o.w = (unsigned)*(const LAS unsigned short*)(s + 6 * CV_ROWB) | ((unsigned)*(const LAS unsigned short*)(s + 7 * CV_ROWB) << 16);
                    *(u32x4*)(ci.dst + (size_t)n * ci.K + 8 * c8) = o; }
                LDS_WAIT(); asm volatile("" ::: "memory"); }
            m_run = total + M63;
        }
#undef ML_LOAD
        __syncthreads();
    }
}

__device__ __forceinline__ void swa_phase(LAS unsigned char* lds, const bf16* QKV, const float* qnw, const float* knw, const float* sinks, bf16* O, int tid, int wave, int lane) {
    constexpr int KSB = 0, KSTR = 144, VTB = 36864, VSTR = 528;
    const int fr = lane & 15, fq = lane >> 4;
    for (int ui = 0; ui < 2; ++ui) {
        const int b = (int)blockIdx.x & 7, uu = ((int)blockIdx.x >> 3) + 32 * ui, kvh = uu >> 4, j = uu & 15;
        const size_t rowb = (size_t)b * SEQ;
#pragma unroll
        for (int i = 0; i < 4; ++i) { const int idx = tid + 512 * i, r = idx >> 3, ch = idx & 7; const int pos = 128 * (j - 1) + r;
            u32x4 kv = (u32x4){0u, 0u, 0u, 0u}, vv = (u32x4){0u, 0u, 0u, 0u};
            if (pos >= 0) { const bf16* sp = QKV + (rowb + pos) * N_QKV + 2048 + kvh * 64 + ch * 8; kv = *(const u32x4*)sp; vv = *(const u32x4*)(sp + 256); }
            float kf[8] = {bflo(kv.x), bfhi(kv.x), bflo(kv.y), bfhi(kv.y), bflo(kv.z), bfhi(kv.z), bflo(kv.w), bfhi(kv.w)};
            float ss = 0.f;
#pragma unroll
            for (int e2 = 0; e2 < 8; ++e2) ss += kf[e2] * kf[e2];
            ss += __shfl_xor(ss, 1); ss += __shfl_xor(ss, 2); ss += __shfl_xor(ss, 4);
            const float rstd = 1.f / sqrtf(ss * (1.f / 64.f) + EPS);
            const f32x4 w0 = *(const f32x4*)(knw + ch * 8), w1 = *(const f32x4*)(knw + ch * 8 + 4);
            u32x4 ko; ko.x = pk2(kf[0] * rstd * w0.x, kf[1] * rstd * w0.y); ko.y = pk2(kf[2] * rstd * w0.z, kf[3] * rstd * w0.w);
            ko.z = pk2(kf[4] * rstd * w1.x, kf[5] * rstd * w1.y); ko.w = pk2(kf[6] * rstd * w1.z, kf[7] * rstd * w1.w);
            *(LAS u32x4*)(lds + KSB + r * KSTR + ch * 16) = ko;
            const unsigned vw[4] = {vv.x, vv.y, vv.z, vv.w};
            const int vo = (((r >> 3) ^ ch) << 4) + (r & 7) * 2;
#pragma unroll
            for (int e2 = 0; e2 < 4; ++e2) {
                *(LAS unsigned short*)(lds + VTB + (ch * 8 + 2 * e2) * VSTR + vo) = (unsigned short)(vw[e2] & 0xffffu);
                *(LAS unsigned short*)(lds + VTB + (ch * 8 + 2 * e2 + 1) * VSTR + vo) = (unsigned short)(vw[e2] >> 16); } }
        __syncthreads();
        const int head = kvh * 8 + wave; const float sink = sinks[head];
        u32x4 qraw[2][2];
#pragma unroll
        for (int h2 = 0; h2 < 2; ++h2) { const bf16* qp = QKV + (rowb + 128 * j + 16 * h2 + fr) * N_QKV + head * 64 + fq * 8; qraw[h2][0] = *(const u32x4*)qp; qraw[h2][1] = *(const u32x4*)(qp + 32); }
        const f32x4 w0 = *(const f32x4*)(qnw + fq * 8), w1 = *(const f32x4*)(qnw + fq * 8 + 4), w2 = *(const f32x4*)(qnw + 32 + fq * 8), w3 = *(const f32x4*)(qnw + 32 + fq * 8 + 4);
        for (int qa = 0; qa < 4; ++qa) {
            const int kstart = 32 * qa;
            bf16x8 qf[2][2]; int qi[2]; size_t tok[2];
#pragma unroll
            for (int h2 = 0; h2 < 2; ++h2) { qi[h2] = 16 * (2 * qa + h2) + fr; tok[h2] = rowb + 128 * j + qi[h2];
                const u32x4 q0 = qraw[h2][0], q1 = qraw[h2][1];
                if (qa + 1 < 4) { const bf16* qp = QKV + (tok[h2] + 32) * N_QKV + head * 64 + fq * 8; qraw[h2][0] = *(const u32x4*)qp; qraw[h2][1] = *(const u32x4*)(qp + 32); }
                float a[8] = {bflo(q0.x), bfhi(q0.x), bflo(q0.y), bfhi(q0.y), bflo(q0.z), bfhi(q0.z), bflo(q0.w), bfhi(q0.w)};
                float c[8] = {bflo(q1.x), bfhi(q1.x), bflo(q1.y), bfhi(q1.y), bflo(q1.z), bfhi(q1.z), bflo(q1.w), bfhi(q1.w)};
                float ss = 0.f;
#pragma unroll
                for (int e2 = 0; e2 < 8; ++e2) ss += a[e2] * a[e2] + c[e2] * c[e2];
                ss += __shfl_xor(ss, 16); ss += __shfl_xor(ss, 32);
                const float rstd = 0.125f / sqrtf(ss * (1.f / 64.f) + EPS);
                u32x4 o0, o1;
                o0.x = pk2(a[0] * rstd * w0.x, a[1] * rstd * w0.y); o0.y = pk2(a[2] * rstd * w0.z, a[3] * rstd * w0.w); o0.z = pk2(a[4] * rstd * w1.x, a[5] * rstd * w1.y); o0.w = pk2(a[6] * rstd * w1.z, a[7] * rstd * w1.w);
                o1.x = pk2(c[0] * rstd * w2.x, c[1] * rstd * w2.y); o1.y = pk2(c[2] * rstd * w2.z, c[3] * rstd * w2.w); o1.z = pk2(c[4] * rstd * w3.x, c[5] * rstd * w3.y); o1.w = pk2(c[6] * rstd * w3.z, c[7] * rstd * w3.w);
                qf[h2][0] = __builtin_bit_cast(bf16x8, o0); qf[h2][1] = __builtin_bit_cast(bf16x8, o1); }
            int Ld[2]; unsigned hiu[2];
#pragma unroll
            for (int h2 = 0; h2 < 2; ++h2) { const int lo = max(1, (j == 0 ? 128 : 0) - qi[h2]); Ld[h2] = 4 * fq - fr - lo; hiu[h2] = (unsigned)(128 - lo); }
            f32x4 sa[2][10]; float mx[2] = {sink, sink};
#pragma unroll
            for (int kt = 0; kt < 10; ++kt) { sa[0][kt] = (f32x4){0.f, 0.f, 0.f, 0.f}; sa[1][kt] = (f32x4){0.f, 0.f, 0.f, 0.f};
#pragma unroll
                for (int kk = 0; kk < 2; ++kk) { const bf16x8 kf = *(const LAS bf16x8*)(lds + KSB + (kstart + 16 * kt + fr) * KSTR + kk * 64 + fq * 16);
                    sa[0][kt] = mfma16(kf, qf[0][kk], sa[0][kt]); sa[1][kt] = mfma16(kf, qf[1][kk], sa[1][kt]); }
#pragma unroll
                for (int h2 = 0; h2 < 2; ++h2)
#pragma unroll
                    for (int i = 0; i < 4; ++i) { const bool valid = (unsigned)(Ld[h2] + (16 * (kt - h2) + i)) <= hiu[h2];
                        sa[h2][kt][i] = valid ? sa[h2][kt][i] : -INFINITY; mx[h2] = fmaxf(mx[h2], sa[h2][kt][i]); } }
            unsigned pw[2][10][2]; float inv[2];
#pragma unroll
            for (int h2 = 0; h2 < 2; ++h2) { float m2 = mx[h2]; m2 = fmaxf(m2, __shfl_xor(m2, 16)); m2 = fmaxf(m2, __shfl_xor(m2, 32));
                float sum = 0.f;
#pragma unroll
                for (int kt = 0; kt < 10; ++kt) { float p[4];
#pragma unroll
                    for (int i = 0; i < 4; ++i) { p[i] = __expf(sa[h2][kt][i] - m2); sum += p[i]; }
                    pw[h2][kt][0] = pk2(p[0], p[1]); pw[h2][kt][1] = pk2(p[2], p[3]); }
                sum += __shfl_xor(sum, 16); sum += __shfl_xor(sum, 32);
                inv[h2] = 1.f / (sum + __expf(sink - m2)); }
#pragma unroll
            for (int dt = 0; dt < 4; ++dt) { f32x4 oa[2] = {(f32x4){0.f, 0.f, 0.f, 0.f}, (f32x4){0.f, 0.f, 0.f, 0.f}};
#pragma unroll
                for (int kb = 0; kb < 5; ++kb) { const int gv = (2 * dt + (fr >> 3)) & 7, b0 = (kstart >> 3) + 4 * kb + (fq >> 1); const LAS unsigned char* vr = lds + VTB + (16 * dt + fr) * VSTR + (fq & 1) * 8;
                    const s16x4 lo = *(const LAS s16x4*)(vr + ((b0 ^ gv) << 4)), hi = *(const LAS s16x4*)(vr + (((b0 + 2) ^ gv) << 4));
                    const bf16x8 vf = (bf16x8){lo[0], lo[1], lo[2], lo[3], hi[0], hi[1], hi[2], hi[3]};
#pragma unroll
                    for (int h2 = 0; h2 < 2; ++h2) { const u32x4 pu = (u32x4){pw[h2][2 * kb][0], pw[h2][2 * kb][1], pw[h2][2 * kb + 1][0], pw[h2][2 * kb + 1][1]};
                        oa[h2] = mfma16(vf, __builtin_bit_cast(bf16x8, pu), oa[h2]); } }
#pragma unroll
                for (int h2 = 0; h2 < 2; ++h2) { const f32x4 ov = oa[h2] * inv[h2];
                    u32x2 w; w.x = pk2(ov.x, ov.y); w.y = pk2(ov.z, ov.w);
                    *(u32x2*)(O + tok[h2] * D + head * 64 + 16 * dt + 4 * fq) = w; } }
        }
        __syncthreads();
    }
}

__device__ __forceinline__ void conv_fixup(const float* __restrict__ SBUF, bf16* __restrict__ A2, const float* __restrict__ cw, const float* __restrict__ cb, const pg8::StaticOrder& S, int tid_) {
    int tid = tid_; asm volatile("" : "+v"(tid));
    pg8::Unit u; int prev = -1;
    for (int i = 0; S.next(i, u); ++i) {
        if (u.pm == prev) continue; prev = u.pm;
        if ((u.pm & 7) == 0) continue;
        const float* tl = SBUF + (size_t)((u.pm - 1) * 4 + 2) * FF2; const float* hd = SBUF + (size_t)(u.pm * 4) * FF2;
        for (int q = tid; q < FF / 4; q += NTHR) { const int c = 4 * q;
            const f32x4 g0 = *(const f32x4*)(tl + c), g1 = *(const f32x4*)(tl + FF2 + c), g2 = *(const f32x4*)(hd + c), g3 = *(const f32x4*)(hd + FF2 + c);
            const f32x4 v0 = *(const f32x4*)(tl + FF + c), v1 = *(const f32x4*)(tl + FF2 + FF + c), v2 = *(const f32x4*)(hd + FF + c), v3 = *(const f32x4*)(hd + FF2 + FF + c);
            const f32x4 a0 = *(const f32x4*)(cw + c), a1 = *(const f32x4*)(cw + FF2 + c), a2 = *(const f32x4*)(cw + 2 * FF2 + c), ab = *(const f32x4*)(cb + c);
            const f32x4 b0 = *(const f32x4*)(cw + FF + c), b1 = *(const f32x4*)(cw + FF2 + FF + c), b2 = *(const f32x4*)(cw + 2 * FF2 + FF + c), bb = *(const f32x4*)(cb + FF + c);
            const f32x4 G0 = a0 * g0 + a1 * g1 + a2 * g2 + ab, G1 = a0 * g1 + a1 * g2 + a2 * g3 + ab, V0 = b0 * v0 + b1 * v1 + b2 * v2 + bb, V1 = b0 * v1 + b1 * v2 + b2 * v3 + bb;
            float o0[4], o1[4];
#pragma unroll
            for (int e2 = 0; e2 < 4; ++e2) { o0[e2] = G0[e2] / (1.f + __expf(-G0[e2])) * V0[e2]; o1[e2] = G1[e2] / (1.f + __expf(-G1[e2])) * V1[e2]; }
            u32x2 w0, w1; w0.x = pk2(o0[0], o0[1]); w0.y = pk2(o0[2], o0[3]); w1.x = pk2(o1[0], o1[1]); w1.y = pk2(o1[2], o1[3]);
            *(u32x2*)(A2 + (size_t)(u.pm * 256) * FF + c) = w0; *(u32x2*)(A2 + (size_t)(u.pm * 256 + 1) * FF + c) = w1;
        }
    }
    asm volatile("s_waitcnt vmcnt(0)" ::: "memory"); __syncthreads();
}
#define XB_TMO      128
#define XB_XCNT(j)  (256  + 64 * (j))
#define XB_XSUB(j)  (1280 + 64 * (j))
#define XB_XGEN(j)  (2304 + 64 * (j))
#define XB_TOP      3328
#define XB_TOPGEN   3392
#define XCD_BAR_WORDS 3456
#define XB_SPIN_CAP (1u << 18)

__device__ __forceinline__ unsigned xb_ld(unsigned* p)              { return __hip_atomic_load(p, __ATOMIC_RELAXED, __HIP_MEMORY_SCOPE_AGENT); }
__device__ __forceinline__ unsigned xb_add(unsigned* p, unsigned v) { return __hip_atomic_fetch_add(p, v, __ATOMIC_RELAXED, __HIP_MEMORY_SCOPE_AGENT); }
__device__ __forceinline__ unsigned xb_xcc_id() { return (unsigned)__builtin_amdgcn_s_getreg((3 << 11) | 20) & 0xFu; }
#define XB_SPIN(cond, bar) do { unsigned _sp = 0; while (cond) { __builtin_amdgcn_s_sleep(1); \
    if ((++_sp & 255u) == 0u) { if (xb_ld(&(bar)[XB_TMO])) break; if (_sp > XB_SPIN_CAP) { atomicAdd(&(bar)[XB_TMO], 1u); break; } } } } while (0)

struct XcdBarrier {
    unsigned* bar; unsigned x;
    volatile LAS unsigned* st;
};

__device__ __forceinline__ XcdBarrier xcd_barrier_post(unsigned* bar, volatile LAS unsigned* st) {
    XcdBarrier b; b.bar = bar; b.x = xb_xcc_id(); b.st = st;
    if (threadIdx.x == 0) (void)xb_add(&bar[XB_XCNT(b.x)], 1u);
    return b;
}
__device__ __forceinline__ void xcd_barrier_complete(unsigned* bar, unsigned x, unsigned& nloc, unsigned& nx) {
    const unsigned G = gridDim.x * gridDim.y * gridDim.z;
    unsigned sum, cnt, mine, sp = 0u;
    for (;;) {
        sum = 0u; cnt = 0u; mine = 0u;
#pragma unroll
        for (unsigned j = 0; j < 16; ++j) { const unsigned c = xb_ld(&bar[XB_XCNT(j)]); sum += c; cnt += (c > 0u) ? 1u : 0u; mine = (j == x) ? c : mine; }
        if (sum == G) break;
        __builtin_amdgcn_s_sleep(1);
        if ((++sp & 255u) == 0u) { if (xb_ld(&bar[XB_TMO])) break; if (sp > XB_SPIN_CAP) { atomicAdd(&bar[XB_TMO], 1u); break; } }
    }
    nloc = mine > 0u ? mine : 1u; nx = cnt > 0u ? cnt : 1u;
}

__device__ __forceinline__ void xcd_barrier(const XcdBarrier& b) {
    asm volatile("s_waitcnt vmcnt(0)" ::: "memory");
    __syncthreads();
    if (threadIdx.x == 0) {
        unsigned* bar = b.bar;
        __builtin_amdgcn_s_waitcnt(0);
        unsigned nloc = b.st[0], nx = b.st[1];
        if (nloc == 0u) { xcd_barrier_complete(bar, b.x, nloc, nx); b.st[0] = nloc; b.st[1] = nx; }
        const unsigned old = xb_add(&bar[XB_XSUB(b.x)], 1u);
        const unsigned gen = old / nloc;
        if (old + 1u == (gen + 1u) * nloc) {
            __builtin_amdgcn_fence(__ATOMIC_RELEASE, "agent");
            asm volatile("s_waitcnt vmcnt(0)" ::: "memory");
            const unsigned og = xb_add(&bar[XB_TOP], 1u);
            const unsigned tg = og / nx;
            if (og + 1u == (tg + 1u) * nx) xb_add(&bar[XB_TOPGEN], 1u);
            else XB_SPIN(xb_ld(&bar[XB_TOPGEN]) == tg, bar);
            __builtin_amdgcn_fence(__ATOMIC_ACQUIRE, "agent");
            xb_add(&bar[XB_XGEN(b.x)], 1u);
            asm volatile("s_waitcnt vmcnt(0)" ::: "memory");
        } else {
            XB_SPIN(xb_ld(&bar[XB_XGEN(b.x)]) == gen, bar);
            __builtin_amdgcn_fence(__ATOMIC_ACQUIRE, "agent");
            asm volatile("s_waitcnt vmcnt(0)" ::: "memory");
        }
    }
    __syncthreads();
}

__device__ __forceinline__ void group_barrier(unsigned* cnt, unsigned nmemb) {
    asm volatile("s_waitcnt vmcnt(0)" ::: "memory");
    __syncthreads();
    if (threadIdx.x == 0) {
        __builtin_amdgcn_fence(__ATOMIC_RELEASE, "agent");
        asm volatile("s_waitcnt vmcnt(0)" ::: "memory");
        const unsigned old = xb_add(cnt, 1u), target = (old / nmemb + 1u) * nmemb;
        unsigned sp = 0u;
        while (xb_ld(cnt) < target) { __builtin_amdgcn_s_sleep(1); if (++sp > (1u << 22)) break; }
        __builtin_amdgcn_fence(__ATOMIC_ACQUIRE, "agent");
        asm volatile("s_waitcnt vmcnt(0)" ::: "memory");
    }
    __syncthreads();
}

struct Params { const float* in[23]; float* out; unsigned char* ws; int ph_lo, ph_hi, use_cg, pad; };
constexpr int N_PHASES = 18;
#ifndef PROBE_D
#define PROBE_D (-1)
#endif
#ifndef PROBE_R
#define PROBE_R (-1)
#endif
#define PROBING (PROBE_D != -1 || PROBE_R != -1)

__global__ void __launch_bounds__(NTHR, 2) fwd_kernel(Params P) {
    extern __shared__ __attribute__((aligned(16))) unsigned char lds_raw[];
    LAS unsigned char* lds = (LAS unsigned char*)lds_raw;
    cg::grid_group grid = cg::this_grid();
    const int tid = threadIdx.x, lane = tid & 63, wave = __builtin_amdgcn_readfirstlane(tid >> 6);
    const int G = gridDim.x, gw = blockIdx.x * NWAVES + wave, NGW = G * NWAVES, gtid = blockIdx.x * NTHR + tid, gthreads = G * NTHR;
    unsigned char* ws = P.ws;
    const float* x = P.in[0]; const float* cvec = P.in[1];
    float* mod0 = (float*)(ws + WS_MOD); float* mod1 = mod0 + 8 * MODW;
    float* Gg = (float*)(ws + WS_G); float* SS = (float*)(ws + WS_SS);
    bf16* WG = (bf16*)(ws + WS_WG); bf16* WA = (bf16*)(ws + WS_W_A); bf16* WB = (bf16*)(ws + WS_W_B); bf16* WC = (bf16*)(ws + WS_W_C); bf16* WD = (bf16*)(ws + WS_W_D);
    bf16* A2 = (bf16*)(ws + WS_A2); bf16* XN = (bf16*)(ws + WS_XN); float* SBUF = (float*)(ws + WS_SB); bf16* QKVO = (bf16*)(ws + WS_QKVO);
    bf16* Hb = (bf16*)(ws + WS_H); bf16* HS = (bf16*)(ws + WS_HS);
    bf16* WA1 = (bf16*)(ws + WS_W1_A); bf16* WB1 = (bf16*)(ws + WS_W1_B); bf16* WC1 = (bf16*)(ws + WS_W1_C); bf16* WD1 = (bf16*)(ws + WS_W1_D);
    const int rowsel = 2048 * ((int)blockIdx.x & 7) + ((int)blockIdx.x >> 3) * NWAVES + wave;
    unsigned* gcnt = (unsigned*)(ws + WS_GBAR) + 64 * ((int)blockIdx.x & 7);
    float* out = P.out;
    const int lo = P.ph_lo, hi = P.ph_hi;
    volatile LAS unsigned* MISC = (volatile LAS unsigned*)(lds + LDS_BYTES - 128);
    if (tid < 32) MISC[tid] = 0u;
    __syncthreads();
    XcdBarrier bar = xcd_barrier_post((unsigned*)(ws + WS_BAR), MISC + 8);
#define IN(k) (lo <= (k) && (k) < hi)
#define GRIDBAR() do { if (P.use_cg) grid.sync(); else xcd_barrier(bar); } while (0)
#define SEAM_(k) do { if (IN(k) && IN((k) + 1)) { if ((k) == 0 || (k) == 3 || G != 256) GRIDBAR(); else group_barrier(gcnt, 32u); } } while (0)
#if PROBING
    unsigned long long tb_d = 0, te_d = 0, tb_r = 0, te_r = 0;
#define SB(k) do { if ((k) == PROBE_D) tb_d = __builtin_amdgcn_s_memrealtime(); if ((k) == PROBE_R) tb_r = __builtin_amdgcn_s_memrealtime(); } while (0)
#define SEAM(k) do { SEAM_(k); if ((k) == PROBE_D) te_d = __builtin_amdgcn_s_memrealtime(); if ((k) == PROBE_R) te_r = __builtin_amdgcn_s_memrealtime(); } while (0)
#else
#define SB(k) do {} while (0)
#define SEAM(k) SEAM_(k)
#endif

    SB(0); if (IN(0)) {
        if (blockIdx.x < 192) { const int w = blockIdx.x, l = w / 96, r = w % 96;
            mod_task(cvec, l ? P.in[12] : P.in[2], l ? P.in[13] : P.in[3], l ? mod1 : mod0, r >> 1, r & 1, lds, tid, wave, lane); }
        const ConvJob j0{P.in[4], WA, 2048, LD_WIN, N_IN, 32 * (N_IN / 32)}, jz{P.in[4], WA, 2048, LD_WIN, N_IN, 0};
        { const bool lite = (G == 256) && blockIdx.x >= 192;
          convert_weights(j0, jz, jz, jz, lds, lite ? 1536 + ((int)(blockIdx.x - 192) * NWAVES + wave) * 2 : gw, lite ? 2 : 1, (G == 256) ? 2560 : NGW, wave, lane); }
        for (int e = gtid; e < 16 * 2048; e += gthreads) { const int g = e >> 11, k = e & 2047; WG[e] = (bf16)f2bf(P.in[4][(size_t)k * LD_WIN + N_IN + g]); }
        __syncthreads();
    }
    SEAM(0);
    SB(1); if (IN(1)) norm_mod_rows(x, XN, mod0 + 0 * 2048, mod0 + 1 * 2048, rowsel, lane);
    SEAM(1);
    SB(2); if (IN(2)) {
        pg8::Gemm g{XN, WA, M, N_IN, D}; pg8::StaticOrder S; S.init(M, N_IN, G, (int)blockIdx.x);
        pg8::EpiBf16<0> E{QKVO, N_IN, nullptr, 1024, 1024, 0.08838834764831845f};
        pg8::gemm_phase<pg8::EpiBf16<0>, pg8::StaticOrder, true, true>(lds, g, S, E);
        gate_gemm(XN, WG, P.in[5], Gg, wave, lane);
    }
    SEAM(2);
    SB(3); if (IN(3)) mlstm_phase(lds, QKVO, Gg, Hb, SS, P.in[7], P.in[8], P.in[11], P.in[14], P.in[18], P.in[19], P.in[22], WB, WC, WD, WA1, WB1, WC1, WD1, gw, NGW, tid, wave, lane);
    SEAM(3);
    SB(4); if (IN(4)) headnorm_rows(Hb, QKVO, SS, P.in[6], HS, rowsel, lane);
    SEAM(4);
    SB(5); if (IN(5)) {
        pg8::Gemm g{HS, WB, M, D, D}; pg8::StaticOrder S; S.init(M, D, G, (int)blockIdx.x);
        pg8::EpiResGate E{x, out, mod0 + 2 * 2048, MODW};
        pg8::gemm_phase<pg8::EpiResGate, pg8::StaticOrder, true, true>(lds, g, S, E);
    }
    SEAM(5);
    SB(6); if (IN(6)) norm_mod_rows(out, XN, mod0 + 3 * 2048, mod0 + 4 * 2048, rowsel, lane);
    SEAM(6);
    SB(7); if (IN(7)) {
        pg8::Gemm g{XN, WC, M, FF2, D}; pg8::StaticOrder S; S.init(M, FF2, G, (int)blockIdx.x);
        pg8::EpiConvAct E{A2, P.in[9], P.in[10], SBUF, lds + 132096};
        pg8::gemm_phase<pg8::EpiConvAct, pg8::StaticOrder, true, true>(lds, g, S, E);
    }
    SEAM(7);
    SB(9); if (IN(9)) {
        pg8::Gemm g{A2, WD, M, D, FF}; pg8::StaticOrder S; S.init(M, D, G, (int)blockIdx.x);
        conv_fixup(SBUF, A2, P.in[9], P.in[10], S, tid);
        pg8::EpiResGate E{out, out, mod0 + 5 * 2048, MODW};
        pg8::gemm_phase<pg8::EpiResGate, pg8::StaticOrder, true, true>(lds, g, S, E);
    }
    SEAM(9);
    SB(10); if (IN(10)) {
        norm_mod_rows(out, XN, mod1 + 0 * 2048, mod1 + 1 * 2048, rowsel, lane);
    }
    SEAM(10);
    SB(11); if (IN(11)) {
        pg8::Gemm g{XN, WA1, M, N_QKV, D}; pg8::StaticOrder S; S.init(M, N_QKV, G, (int)blockIdx.x);
        pg8::EpiBf16<0> E{QKVO, N_QKV, nullptr, 0, 0, 1.f};
        pg8::gemm_phase<pg8::EpiBf16<0>, pg8::StaticOrder, true, true>(lds, g, S, E);
    }
    SEAM(11);
    SB(12); if (IN(12)) swa_phase(lds, QKVO, P.in[15], P.in[16], P.in[17], Hb, tid, wave, lane);
    SEAM(12);
    SB(13); if (IN(13)) {
        pg8::Gemm g{Hb, WB1, M, D, D}; pg8::StaticOrder S; S.init(M, D, G, (int)blockIdx.x);
        pg8::EpiResGate E{out, out, mod1 + 2 * 2048, MODW};
        pg8::gemm_phase<pg8::EpiResGate, pg8::StaticOrder, true, true>(lds, g, S, E);
    }
    SEAM(13);
    SB(14); if (IN(14)) norm_mod_rows(out, XN, mod1 + 3 * 2048, mod1 + 4 * 2048, rowsel, lane);
    SEAM(14);
    SB(15); if (IN(15)) {
        pg8::Gemm g{XN, WC1, M, FF2, D}; pg8::StaticOrder S; S.init(M, FF2, G, (int)blockIdx.x);
        pg8::EpiConvAct E{A2, P.in[20], P.in[21], SBUF, lds + 132096};
        pg8::gemm_phase<pg8::EpiConvAct, pg8::StaticOrder, true, true>(lds, g, S, E);
    }
    SEAM(15);
    SB(17); if (IN(17)) {
        pg8::Gemm g{A2, WD1, M, D, FF}; pg8::StaticOrder S; S.init(M, D, G, (int)blockIdx.x);
        conv_fixup(SBUF, A2, P.in[20], P.in[21], S, tid);
        pg8::EpiResGate E{out, out, mod1 + 5 * 2048, MODW};
        pg8::gemm_phase<pg8::EpiResGate, pg8::StaticOrder, true, true>(lds, g, S, E);
    }
#if PROBING
    GRIDBAR();
    { const unsigned long long tn = __builtin_amdgcn_s_memrealtime();
      if (17 == PROBE_D) te_d = tn; if (17 == PROBE_R) te_r = tn;
      if (PROBE_D == 200 || PROBE_R == 200) { GRIDBAR(); const unsigned long long t0 = __builtin_amdgcn_s_memrealtime(); GRIDBAR(); const unsigned long long t1 = __builtin_amdgcn_s_memrealtime();
          if (PROBE_D == 200) { tb_d = t0; te_d = t1; } if (PROBE_R == 200) { tb_r = t0; te_r = t1; } }
      if (blockIdx.x == 0) {
          if (PROBE_R != -1) { const int K = (PROBE_R == -2) ? 20000 : (PROBE_R == 200 ? (int)(te_r - tb_r) : (int)((te_r - tb_r) / 100ull)); for (int i = tid; i < K; i += NTHR) out[i] += 0.25f; }
          if (PROBE_D != -1) { const unsigned long long t0 = __builtin_amdgcn_s_memrealtime(), w = (PROBE_D == 200 ? 800ull : 8ull) * (te_d - tb_d); while (__builtin_amdgcn_s_memrealtime() - t0 < w) __builtin_amdgcn_s_sleep(8); } } }
#endif
#undef IN
#undef SEAM
}

#ifndef ONE_LAUNCH
#define ONE_LAUNCH 1
#endif
extern "C" void kernel_launch(void* const* d_in, const int* in_sizes, int n_in, void* d_out, int out_size, void* d_ws, size_t ws_size, hipStream_t stream) {
    static int grid = 0;
    if (grid == 0) {
        if (n_in != 23 || in_sizes[0] != M * D || out_size != M * D || ws_size < WS_END) { fprintf(stderr, "kernel_launch: unexpected shapes (n_in %d, ws %zu); nothing launched\n", n_in, ws_size); grid = -1; return; }
        int dev = 0, cus = 0, per_cu = 0;
        if (hipGetDevice(&dev) != hipSuccess || hipDeviceGetAttribute(&cus, hipDeviceAttributeMultiprocessorCount, dev) != hipSuccess) { grid = -1; return; }
        if (hipFuncSetAttribute((const void*)fwd_kernel, hipFuncAttributeMaxDynamicSharedMemorySize, LDS_BYTES) != hipSuccess) { fprintf(stderr, "kernel_launch: hipFuncSetAttribute failed\n"); grid = -1; return; }
        if (hipOccupancyMaxActiveBlocksPerMultiprocessor(&per_cu, (const void*)fwd_kernel, NTHR, LDS_BYTES) != hipSuccess || per_cu < 1) { fprintf(stderr, "kernel_launch: occupancy query says %d\n", per_cu); per_cu = 1; }
        (void)hipGetLastError();
        grid = cus;
    }
    if (grid < 0) return;
    (void)hipMemsetAsync((char*)d_ws, 0, CTL_ZERO_BYTES, stream);
    Params p{};
    for (int i = 0; i < 23; ++i) p.in[i] = (const float*)d_in[i];
    p.out = (float*)d_out; p.ws = (unsigned char*)d_ws;
#if ONE_LAUNCH
    p.ph_lo = 0; p.ph_hi = N_PHASES;
    void* args[] = {&p};
    hipError_t e = hipLaunchCooperativeKernel((const void*)fwd_kernel, dim3(grid), dim3(NTHR), args, LDS_BYTES, stream);
    if (e != hipSuccess) fprintf(stderr, "cooperative launch failed: %s (grid %d)\n", hipGetErrorString(e), grid);
#else
    for (int ph = 0; ph < N_PHASES; ++ph) { p.ph_lo = ph; p.ph_hi = ph + 1; hipLaunchKernelGGL(fwd_kernel, dim3(grid), dim3(NTHR), LDS_BYTES, stream, p); }
#endif
}
```
